# Optimizing an MI355X kernel written in HIP

```python
import jax, jax.numpy as jnp
from jax import lax
import numpy as np

D_MODEL = 2048
BATCH = 2
SEQ = 4096
DEPTH = 4

N_BRANCH = 3
NORM_EPS = 1e-6
POOL_WINDOWS = (2, 4, 8, 16)
POOL_GROUPS = 4
POOL_WIDTH = D_MODEL // 2
POOL_GROUP_DIM = POOL_WIDTH // POOL_GROUPS
SSM_INNER = D_MODEL
SSM_HEAD_DIM = 64
SSM_HEADS = SSM_INNER // SSM_HEAD_DIM
SSM_GROUPS = 4
SSM_HEADS_PER_GROUP = SSM_HEADS // SSM_GROUPS
SSM_STATE = 128
SSM_CONV = 4
SSM_CONV_DIM = SSM_INNER + 2 * SSM_GROUPS * SSM_STATE
SSM_CHUNK = 128
SC_WIDTH = D_MODEL // 2
SC_KERNEL = 3
IN_SPLITS = (POOL_WIDTH, POOL_WIDTH, SSM_INNER, SSM_CONV_DIM, SSM_HEADS, SC_WIDTH, SC_WIDTH, SC_WIDTH, SC_WIDTH, N_BRANCH * D_MODEL)
IN_PROJ_DIM = 2 * POOL_WIDTH + SSM_INNER + SSM_CONV_DIM + SSM_HEADS + 4 * SC_WIDTH + N_BRANCH * D_MODEL

kernel_name = 'hybrid_pool_ssd_shortconv_gated_merge'


def rms_norm(x, w):
    xf = x.astype(jnp.float32)
    xf = xf * lax.rsqrt(jnp.mean(xf * xf, axis=-1, keepdims=True) + NORM_EPS)
    return (xf * w.astype(jnp.float32)).astype(x.dtype)


def causal_depthwise_conv(x, w):
    k, c = w.shape
    return lax.conv_general_dilated(x, w[:, None, :].astype(x.dtype), window_strides=(1,), padding=[(k - 1, 0)], dimension_numbers=('NWC', 'WIO', 'NWC'), feature_group_count=c)


def pool_mixer(u, gate, w_grp, scale):
    b, s, _ = u.shape
    cs = jnp.cumsum(u.astype(jnp.float32), axis=1)
    pos = jnp.arange(1, s + 1, dtype=jnp.float32)[None, :, None]
    outs = []
    for g, win in enumerate(POOL_WINDOWS):
        sl = slice(g * POOL_GROUP_DIM, (g + 1) * POOL_GROUP_DIM)
        csg = cs[..., sl]
        lagged = jnp.pad(csg[:, :s - win], ((0, 0), (win, 0), (0, 0)))
        mean = (csg - lagged) / jnp.minimum(pos, win)
        outs.append(mean - u[..., sl].astype(jnp.float32))
    d = jnp.stack(outs, axis=2).astype(u.dtype)
    y = jnp.einsum('bsgc,gcd->bsgd', d, w_grp).reshape(b, s, POOL_WIDTH)
    return y * scale * jax.nn.silu(gate)


def ssd_mixer(xbc, z, dt_raw, conv_w, conv_b, dt_bias, a_log, d_skip, norm_w):
    b, s, _ = xbc.shape
    c, l = s // SSM_CHUNK, SSM_CHUNK
    G, E, P, N = SSM_GROUPS, SSM_HEADS_PER_GROUP, SSM_HEAD_DIM, SSM_STATE
    f32 = jnp.float32
    xbc = jax.nn.silu(causal_depthwise_conv(xbc, conv_w) + conv_b)
    xs, bm, cm = jnp.split(xbc, [SSM_INNER, SSM_INNER + G * N], axis=-1)
    dt = jax.nn.softplus(dt_raw.astype(f32) + dt_bias.astype(f32))
    a = -jnp.exp(a_log.astype(f32))
    xh = xs.reshape(b, c, l, G, E, P).astype(f32)
    bm = bm.reshape(b, c, l, G, N).astype(f32)
    cm = cm.reshape(b, c, l, G, N).astype(f32)
    dtc = dt.reshape(b, c, l, G, E)
    xdt = xh * dtc[..., None]
    log_a = jnp.moveaxis(dtc * a.reshape(G, E), 2, -1)
    a_cum = jnp.cumsum(log_a, axis=-1)
    causal = jnp.tril(jnp.ones((l, l), dtype=bool))
    seg = a_cum[..., :, None] - a_cum[..., None, :]
    decay = jnp.exp(jnp.where(causal, seg, -jnp.inf))
    cb = jnp.einsum('bclgn,bcsgn->bcgls', cm, bm)
    y_diag = jnp.einsum('bcgels,bcsgep->bclgep', cb[:, :, :, None] * decay, xdt)
    to_end = jnp.moveaxis(jnp.exp(a_cum[..., -1:] - a_cum), -1, 2)
    states = jnp.einsum('bclgn,bclgep->bcgepn', bm, xdt * to_end[..., None])
    chunk_decay = jnp.exp(a_cum[..., -1])

    def step(carry, inp):
        st, dec = inp
        return carry * dec[..., None, None] + st, carry

    init = jnp.zeros((b, G, E, P, N), f32)
    _, prev = lax.scan(step, init, (jnp.moveaxis(states, 1, 0), jnp.moveaxis(chunk_decay, 1, 0)))
    prev = jnp.moveaxis(prev, 0, 1)
    from_start = jnp.moveaxis(jnp.exp(a_cum), -1, 2)
    y_off = jnp.einsum('bclgn,bcgepn->bclgep', cm, prev) * from_start[..., None]
    y = y_diag + y_off + xh * d_skip.astype(f32).reshape(G, E, 1)
    y = y.reshape(b, s, SSM_INNER) * jax.nn.silu(z.astype(f32))
    yg = y.reshape(b, s, G, SSM_INNER // G)
    yg = yg * lax.rsqrt(jnp.mean(yg * yg, axis=-1, keepdims=True) + NORM_EPS)
    return (yg.reshape(b, s, SSM_INNER) * norm_w.astype(f32)).astype(z.dtype)


def short_conv_mixer(bg, cg, v, gate, conv_w):
    y = bg * causal_depthwise_conv(cg * v, conv_w)
    return y * jax.nn.silu(gate)


def setup_inputs(seed: int = 0) -> dict:
    key = jax.random.key(seed)
    ks = jax.random.split(key, 20)
    f32 = jnp.float32

    def normal(k, shape, scale):
        return jax.random.normal(k, shape, f32) * scale

    x = normal(ks[0], (BATCH, SEQ, D_MODEL), 1.0)
    norm_w = 1.0 + normal(ks[1], (DEPTH, D_MODEL), 0.02)
    w_in = normal(ks[2], (DEPTH, D_MODEL, IN_PROJ_DIM), D_MODEL ** -0.5)
    b_gate = normal(ks[3], (DEPTH, N_BRANCH * D_MODEL), 0.02)
    pool_w = normal(ks[4], (DEPTH, POOL_GROUPS, POOL_GROUP_DIM, POOL_GROUP_DIM), POOL_GROUP_DIM ** -0.5)
    pool_scale = 1.0 + normal(ks[5], (DEPTH, POOL_WIDTH), 0.02)
    ssm_conv_w = normal(ks[6], (DEPTH, SSM_CONV, SSM_CONV_DIM), SSM_CONV ** -0.5)
    ssm_conv_b = normal(ks[7], (DEPTH, SSM_CONV_DIM), 0.02)
    dt0 = jnp.exp(jax.random.uniform(ks[8], (DEPTH, SSM_HEADS), f32) * (np.log(0.1) - np.log(0.001)) + np.log(0.001))
    ssm_dt_bias = dt0 + jnp.log(-jnp.expm1(-dt0))
    ssm_a_log = jnp.log(jax.random.uniform(ks[9], (DEPTH, SSM_HEADS), f32, minval=1.0, maxval=16.0))
    ssm_d = 1.0 + normal(ks[10], (DEPTH, SSM_HEADS), 0.02)
    ssm_norm_w = 1.0 + normal(ks[11], (DEPTH, SSM_INNER), 0.02)
    sc_conv_w = normal(ks[12], (DEPTH, SC_KERNEL, SC_WIDTH), SC_KERNEL ** -0.5)
    w_br_pool = normal(ks[13], (DEPTH, POOL_WIDTH, D_MODEL), POOL_WIDTH ** -0.5)
    w_br_ssm = normal(ks[14], (DEPTH, SSM_INNER, D_MODEL), SSM_INNER ** -0.5)
    w_br_conv = normal(ks[15], (DEPTH, SC_WIDTH, D_MODEL), SC_WIDTH ** -0.5)
    w_out = normal(ks[16], (DEPTH, D_MODEL, D_MODEL), D_MODEL ** -0.5)
    final_norm_w = 1.0 + normal(ks[17], (D_MODEL,), 0.02)
    return {'x': x, 'norm_w': norm_w, 'w_in': w_in, 'b_gate': b_gate, 'pool_w': pool_w, 'pool_scale': pool_scale, 'ssm_conv_w': ssm_conv_w, 'ssm_conv_b': ssm_conv_b, 'ssm_dt_bias': ssm_dt_bias, 'ssm_a_log': ssm_a_log, 'ssm_d': ssm_d, 'ssm_norm_w': ssm_norm_w, 'sc_conv_w': sc_conv_w, 'w_br_pool': w_br_pool, 'w_br_ssm': w_br_ssm, 'w_br_conv': w_br_conv, 'w_out': w_out, 'final_norm_w': final_norm_w}


def reference(x, norm_w, w_in, b_gate, pool_w, pool_scale, ssm_conv_w, ssm_conv_b, ssm_dt_bias, ssm_a_log, ssm_d, ssm_norm_w, sc_conv_w, w_br_pool, w_br_ssm, w_br_conv, w_out, final_norm_w):
    b, s, _ = x.shape
    offsets = np.cumsum(IN_SPLITS)[:-1].tolist()
    for i in range(DEPTH):
        h = rms_norm(x, norm_w[i])
        proj = h @ w_in[i]
        (p_u, p_g, m_z, m_xbc, m_dt, c_b, c_c, c_v, c_g, g_logit) = jnp.split(proj, offsets, axis=-1)
        gates = jax.nn.sigmoid(g_logit + b_gate[i]).reshape(b, s, N_BRANCH, D_MODEL)
        y_a = pool_mixer(p_u, p_g, pool_w[i], pool_scale[i]) @ w_br_pool[i]
        y_b = ssd_mixer(m_xbc, m_z, m_dt, ssm_conv_w[i], ssm_conv_b[i], ssm_dt_bias[i], ssm_a_log[i], ssm_d[i], ssm_norm_w[i]) @ w_br_ssm[i]
        y_c = short_conv_mixer(c_b, c_c, c_v, c_g, sc_conv_w[i]) @ w_br_conv[i]
        merged = gates[:, :, 0] * y_a + gates[:, :, 1] * y_b + gates[:, :, 2] * y_c
        x = x + merged @ w_out[i]
    return rms_norm(x, final_norm_w)
```

```cpp
#include <hip/hip_runtime.h>
#include <hip/hip_cooperative_groups.h>
#include <cstdio>
#include <cstdint>
namespace cg = cooperative_groups;

#define LAS __attribute__((address_space(3)))
typedef unsigned short bf16_t;
typedef short bf16x8 __attribute__((ext_vector_type(8)));
typedef float f32x4 __attribute__((ext_vector_type(4)));
typedef unsigned u32x4 __attribute__((ext_vector_type(4)));
typedef unsigned u32x2 __attribute__((ext_vector_type(2)));

constexpr int M_TOK = 8192, DM = 2048, NPROJ = 17408, NIN_PAD = 17664, NIN_SRC = 17440;
constexpr int LDS_BYTES = 163840;
constexpr float EPS = 1e-6f;

constexpr size_t al256(size_t b) { return (b + 255) & ~(size_t)255; }
constexpr size_t OFF_BT_IN = 0;
constexpr size_t OFF_BT_GRP = OFF_BT_IN + al256((size_t)4 * NIN_PAD * DM * 2);
constexpr size_t OFF_BT_BR = OFF_BT_GRP + al256((size_t)4 * 1024 * 256 * 2);
constexpr size_t OFF_BT_OUT = OFF_BT_BR + al256((size_t)4 * DM * 4096 * 2);
constexpr size_t OFF_XCUR = OFF_BT_OUT + al256((size_t)4 * DM * DM * 2);
constexpr size_t OFF_H = OFF_XCUR + al256((size_t)M_TOK * DM * 4);
constexpr size_t OFF_PROJ = OFF_H + al256((size_t)M_TOK * DM * 2);
constexpr size_t OFF_DT = OFF_PROJ + al256((size_t)M_TOK * NPROJ * 2);
constexpr size_t OFF_DPOOL = OFF_DT + al256((size_t)M_TOK * 32 * 4);
constexpr size_t OFF_XBC = OFF_DPOOL + al256((size_t)M_TOK * 1024 * 2);
constexpr size_t OFF_ACT = OFF_XBC + al256((size_t)M_TOK * 3072 * 2);
constexpr size_t OFF_STATES = OFF_ACT + al256((size_t)M_TOK * 4096 * 2);
constexpr size_t OFF_PREV = OFF_STATES + al256((size_t)64 * 32 * 8192 * 4);
constexpr size_t OFF_DECAY = OFF_PREV + al256((size_t)64 * 32 * 8192 * 2);
constexpr size_t OFF_MERGED = OFF_DECAY + al256((size_t)64 * 32 * 4);
constexpr size_t OFF_GATES = OFF_MERGED + al256((size_t)M_TOK * DM * 2);
constexpr size_t OFF_BAR = OFF_GATES + al256((size_t)4 * M_TOK * DM * 2);
constexpr size_t OFF_ROWSQ = OFF_BAR + 16384;
constexpr size_t WS_END = OFF_ROWSQ + 32768;

struct Params {
    const float *x, *norm_w, *w_in, *b_gate, *pool_w, *pool_scale, *ssm_conv_w, *ssm_conv_b, *ssm_dt_bias, *ssm_a_log, *ssm_d,
        *ssm_norm_w, *sc_conv_w, *w_br_pool, *w_br_ssm, *w_br_conv, *w_out, *final_norm_w;
    float* out;
    unsigned char* ws;
    __device__ __forceinline__ bf16_t* bt_in() const { return (bf16_t*)(ws + OFF_BT_IN); }
    __device__ __forceinline__ bf16_t* bt_grp() const { return (bf16_t*)(ws + OFF_BT_GRP); }
    __device__ __forceinline__ bf16_t* bt_br() const { return (bf16_t*)(ws + OFF_BT_BR); }
    __device__ __forceinline__ bf16_t* bt_out() const { return (bf16_t*)(ws + OFF_BT_OUT); }
    __device__ __forceinline__ float* xcur() const { return (float*)(ws + OFF_XCUR); }
    __device__ __forceinline__ bf16_t* h() const { return (bf16_t*)(ws + OFF_H); }
    __device__ __forceinline__ bf16_t* proj() const { return (bf16_t*)(ws + OFF_PROJ); }
    __device__ __forceinline__ float* dt() const { return (float*)(ws + OFF_DT); }
    __device__ __forceinline__ bf16_t* dpool() const { return (bf16_t*)(ws + OFF_DPOOL); }
    __device__ __forceinline__ bf16_t* xbc() const { return (bf16_t*)(ws + OFF_XBC); }
    __device__ __forceinline__ bf16_t* act() const { return (bf16_t*)(ws + OFF_ACT); }
    __device__ __forceinline__ float* states() const { return (float*)(ws + OFF_STATES); }
    __device__ __forceinline__ bf16_t* prev() const { return (bf16_t*)(ws + OFF_PREV); }
    __device__ __forceinline__ float* decay() const { return (float*)(ws + OFF_DECAY); }
    __device__ __forceinline__ bf16_t* merged() const { return (bf16_t*)(ws + OFF_MERGED); }
    __device__ __forceinline__ bf16_t* gates() const { return (bf16_t*)(ws + OFF_GATES); }
    __device__ __forceinline__ unsigned* bar() const { return (unsigned*)(ws + OFF_BAR); }
    __device__ __forceinline__ float* rowsq() const { return (float*)(ws + OFF_ROWSQ); }
};

__device__ __forceinline__ unsigned pk2(float lo, float hi) { unsigned r; asm volatile("v_cvt_pk_bf16_f32 %0, %1, %2" : "=v"(r) : "v"(lo), "v"(hi)); return r; }
__device__ __forceinline__ float bflo(unsigned v) { return __uint_as_float(v << 16); }
__device__ __forceinline__ float bfhi(unsigned v) { return __uint_as_float(v & 0xffff0000u); }
__device__ __forceinline__ void unpack8(const u32x4 v, float (&f)[8]) {
    f[0] = bflo(v.x); f[1] = bfhi(v.x); f[2] = bflo(v.y); f[3] = bfhi(v.y); f[4] = bflo(v.z); f[5] = bfhi(v.z); f[6] = bflo(v.w); f[7] = bfhi(v.w);
}
__device__ __forceinline__ u32x4 pack8(const float (&f)[8]) { u32x4 o; o.x = pk2(f[0], f[1]); o.y = pk2(f[2], f[3]); o.z = pk2(f[4], f[5]); o.w = pk2(f[6], f[7]); return o; }
__device__ __forceinline__ float sigmoidf_(float v) { return __builtin_amdgcn_rcpf(1.f + __builtin_amdgcn_exp2f(-1.44269504f * v)); }
__device__ __forceinline__ float siluf_(float v) { return v * __builtin_amdgcn_rcpf(1.f + __builtin_amdgcn_exp2f(-1.44269504f * v)); }
__device__ __forceinline__ float softplusf_(float v) { return v > 20.f ? v : log1pf(expf(v)); }
__device__ __forceinline__ float wave_sum(float v) {
#pragma unroll
    for (int o = 1; o < 64; o <<= 1) v += __shfl_xor(v, o);
    return v;
}
__device__ __forceinline__ float wave_scan_incl(float v, int lane) {
#pragma unroll
    for (int o = 1; o < 64; o <<= 1) { const float t = __shfl_up(v, o); if (lane >= o) v += t; }
    return v;
}
__device__ __forceinline__ int opq(int v) { asm volatile("" : "+v"(v)); return v; }
__device__ __forceinline__ unsigned lds_addr(LAS const void* p) { return (unsigned)(uintptr_t)p; }
__device__ __forceinline__ bf16x8 mk_frag(u32x2 a, u32x2 b) { u32x4 r; r.x = a.x; r.y = a.y; r.z = b.x; r.w = b.y; return __builtin_bit_cast(bf16x8, r); }
template <int OFF2>
__device__ __forceinline__ bf16x8 tr_frag(unsigned addr) {
    u32x2 a, b;
    asm volatile("ds_read_b64_tr_b16 %0, %2\n\tds_read_b64_tr_b16 %1, %2 offset:%3\n\ts_waitcnt lgkmcnt(0)" : "=&v"(a), "=&v"(b) : "v"(addr), "n"(OFF2) : "memory");
    return mk_frag(a, b);
}
template <int OFF2, int STRIDE>
__device__ __forceinline__ void tr_frag2(unsigned addr, bf16x8& f0, bf16x8& f1) {
    u32x2 a0, b0, a1, b1;
    asm volatile("ds_read_b64_tr_b16 %0, %4\n\tds_read_b64_tr_b16 %1, %4 offset:%5\n\tds_read_b64_tr_b16 %2, %4 offset:%6\n\tds_read_b64_tr_b16 %3, %4 offset:%7\n\ts_waitcnt lgkmcnt(0)"
                 : "=&v"(a0), "=&v"(b0), "=&v"(a1), "=&v"(b1) : "v"(addr), "n"(OFF2), "n"(STRIDE), "n"(STRIDE + OFF2) : "memory");
    f0 = mk_frag(a0, b0); f1 = mk_frag(a1, b1);
}
template <int OFF2, int STRIDE>
__device__ __forceinline__ void tr_frag4(unsigned addr, bf16x8 (&f)[4]) {
    u32x2 a0, b0, a1, b1, a2, b2, a3, b3;
    asm volatile("ds_read_b64_tr_b16 %0, %8\n\tds_read_b64_tr_b16 %1, %8 offset:%9\n\tds_read_b64_tr_b16 %2, %8 offset:%10\n\tds_read_b64_tr_b16 %3, %8 offset:%11\n\t"
                 "ds_read_b64_tr_b16 %4, %8 offset:%12\n\tds_read_b64_tr_b16 %5, %8 offset:%13\n\tds_read_b64_tr_b16 %6, %8 offset:%14\n\tds_read_b64_tr_b16 %7, %8 offset:%15\n\ts_waitcnt lgkmcnt(0)"
                 : "=&v"(a0), "=&v"(b0), "=&v"(a1), "=&v"(b1), "=&v"(a2), "=&v"(b2), "=&v"(a3), "=&v"(b3)
                 : "v"(addr), "n"(OFF2), "n"(STRIDE), "n"(STRIDE + OFF2), "n"(2 * STRIDE), "n"(2 * STRIDE + OFF2), "n"(3 * STRIDE), "n"(3 * STRIDE + OFF2) : "memory");
    f[0] = mk_frag(a0, b0); f[1] = mk_frag(a1, b1); f[2] = mk_frag(a2, b2); f[3] = mk_frag(a3, b3);
}

template <int OFF2, int O1, int O2, int O3>
__device__ __forceinline__ void tr_frag4o(unsigned addr, bf16x8 (&f)[4]) {
    u32x2 a0, b0, a1, b1, a2, b2, a3, b3;
    asm volatile("ds_read_b64_tr_b16 %0, %8\n\tds_read_b64_tr_b16 %1, %8 offset:%9\n\tds_read_b64_tr_b16 %2, %8 offset:%10\n\tds_read_b64_tr_b16 %3, %8 offset:%11\n\t"
                 "ds_read_b64_tr_b16 %4, %8 offset:%12\n\tds_read_b64_tr_b16 %5, %8 offset:%13\n\tds_read_b64_tr_b16 %6, %8 offset:%14\n\tds_read_b64_tr_b16 %7, %8 offset:%15\n\ts_waitcnt lgkmcnt(0)"
                 : "=&v"(a0), "=&v"(b0), "=&v"(a1), "=&v"(b1), "=&v"(a2), "=&v"(b2), "=&v"(a3), "=&v"(b3)
                 : "v"(addr), "n"(OFF2), "n"(O1), "n"(O1 + OFF2), "n"(O2), "n"(O2 + OFF2), "n"(O3), "n"(O3 + OFF2) : "memory");
    f[0] = mk_frag(a0, b0); f[1] = mk_frag(a1, b1); f[2] = mk_frag(a2, b2); f[3] = mk_frag(a3, b3);
}

constexpr int BM = 256, BK = 64, HALF = 128, HTB = HALF * BK * 2, NXCD = 8, WGM = 8;
__device__ __forceinline__ int lds_byte(int r, int c) { const int st = (r >> 4) * 2 + (c >> 5), rr = r & 15, cc = c & 31, ob = rr * 64 + cc * 2; return st * 1024 + (ob ^ (((ob >> 9) & 1) << 5)); }
__device__ __forceinline__ void stage_rc(int b, int& R, int& C) { const int st = b / 1024, sb = b % 1024, swz = sb ^ (((sb >> 9) & 1) << 5); R = (st >> 1) * 16 + swz / 64; C = (st & 1) * 32 + (swz % 64) / 2; }
__device__ __forceinline__ int perm32(int rho) { const int n = rho >> 4, i = rho & 15; return 8 * (i >> 2) + 4 * n + (i & 3); }

struct Unit { int pm, pn; };
struct Gemm { const bf16_t* A; const bf16_t* Bt; int lda, ldb, K, nM, nN, a_pn_off; };
struct StaticOrder {
    int nM, nN, nwg, G, c;
    __device__ void init(int nM_, int nN_, int G_, int c_) { nM = nM_; nN = nN_; nwg = nM * nN; G = G_; c = c_; }
    __device__ bool next(int i, Unit& u) const {
        const long L = (long)i * G + c; if (L >= nwg) return false;
        int wgid = (int)L; { const int q = nwg / NXCD, r = nwg % NXCD, xcd = wgid % NXCD, off = wgid / NXCD; wgid = (xcd < r ? xcd * (q + 1) : r * (q + 1) + (xcd - r) * q) + off; }
        const int nig = WGM * nN, gid = wgid / nig, fm = gid * WGM, gsz = (nM - fm) < WGM ? (nM - fm) : WGM;
        u.pm = fm + ((wgid % nig) % gsz); u.pn = (wgid % nig) / gsz; return true;
    }
};

template <class Epi, bool ALIGN_EPI = false, bool SP2 = true>
__device__ __forceinline__ void gemm_phase(LAS unsigned char* lds, const Gemm g, const StaticOrder& S, const Epi& E) {
    const int tid = opq(threadIdx.x), wid = __builtin_amdgcn_readfirstlane(tid >> 6), lane = tid & 63, wr = wid >> 2, wc = wid & 3, fr = lane & 15, fq = lane >> 4;
    int K_ = g.K; asm volatile("" : "+s"(K_)); const int K = K_, nt = K / BK;
    unsigned voffA[2], voffB[2];
#pragma unroll
    for (int i = 0; i < 2; ++i) { int R, C; stage_rc(tid * 16 + i * 8192, R, C); const int Rb = (R & ~31) + perm32(R & 31);
        voffA[i] = (unsigned)(R * g.lda + C) * 2u; voffB[i] = (unsigned)(Rb * g.ldb + C) * 2u; }
    const size_t kstep = (size_t)(BK * 2);
    const size_t hstepA = (size_t)HALF * g.lda * 2, hstepB = (size_t)HALF * g.ldb * 2;
    const size_t tstepA = 2 * hstepA, tstepB = 2 * hstepB;
    const unsigned ldsw = (unsigned)wid * 1024u;
    const int aoff = lds_byte(wr * 64 + fr, fq * 8), boff = lds_byte(wc * 32 + fr, fq * 8);
#define PG8_SA(b, h) (((b) * 2 + (h)) * HTB)
#define PG8_SB(b, h) ((4 + (b) * 2 + (h)) * HTB)
#define PG8_STAGE(bufoff, gbase, voff) do { _Pragma("unroll") for (int _i = 0; _i < 2; ++_i) \
        __builtin_amdgcn_global_load_lds((const unsigned*)((const char*)(gbase) + (voff)[_i]), (LAS unsigned*)(lds + (bufoff) + ldsw + _i * 8192), 16, 0, 0); } while (0)
#define PG8_LDA(dst, b, h) do { _Pragma("unroll") for (int m = 0; m < 4; ++m) _Pragma("unroll") for (int k = 0; k < 2; ++k) dst[m][k] = *(const LAS bf16x8*)(lds + PG8_SA(b, h) + aoff + m * 2048 + k * 1024); } while (0)
#define PG8_LDB(dst, b, h) do { _Pragma("unroll") for (int n = 0; n < 2; ++n) _Pragma("unroll") for (int k = 0; k < 2; ++k) dst[n][k] = *(const LAS bf16x8*)(lds + PG8_SB(b, h) + boff + n * 2048 + k * 1024); } while (0)
#define PG8_MMA(ai, bj, At, Bt) do { __builtin_amdgcn_s_setprio(1); _Pragma("unroll") for (int m = 0; m < 4; ++m) _Pragma("unroll") for (int n = 0; n < 2; ++n) _Pragma("unroll") for (int k = 0; k < 2; ++k) \
        acc[ai][bj][m][n] = __builtin_amdgcn_mfma_f32_16x16x32_bf16(Bt[n][k], At[m][k], acc[ai][bj][m][n], 0, 0, 0); __builtin_amdgcn_s_setprio(0); } while (0)
#define PG8_WAIT_V(n) asm volatile("s_waitcnt vmcnt(" #n ")" ::: "memory")
#define PG8_WAIT_L(n) asm volatile("s_waitcnt lgkmcnt(" #n ")" ::: "memory")
#define PG8_BAR __builtin_amdgcn_s_barrier()
#define PG8_SCHED __builtin_amdgcn_sched_barrier(0)
    Unit cur, nxt; int ui = 0;
    if (!S.next(0, cur)) return;
    f32x4 acc[2][2][4][2];
#pragma unroll
    for (int a = 0; a < 2; ++a)
#pragma unroll
        for (int b = 0; b < 2; ++b)
#pragma unroll
            for (int m = 0; m < 4; ++m)
#pragma unroll
                for (int n = 0; n < 2; ++n) acc[a][b][m][n] = (f32x4){0.f, 0.f, 0.f, 0.f};
    bf16x8 At[4][2], B0[2][2], B1[2][2];
    const char* cA = (const char*)g.A + (size_t)cur.pm * tstepA + (size_t)cur.pn * g.a_pn_off * 2; const char* cB = (const char*)g.Bt + (size_t)cur.pn * tstepB;
    if constexpr (SP2) {
        PG8_STAGE(PG8_SB(0, 0), cB, voffB); PG8_STAGE(PG8_SB(0, 1), cB + hstepB, voffB); PG8_STAGE(PG8_SA(0, 0), cA, voffA); PG8_STAGE(PG8_SA(0, 1), cA + hstepA, voffA);
        if (wr == 1) PG8_BAR;
        PG8_WAIT_V(2); PG8_BAR;
        PG8_STAGE(PG8_SB(1, 0), cB + kstep, voffB); PG8_STAGE(PG8_SA(1, 0), cA + kstep, voffA); PG8_STAGE(PG8_SB(1, 1), cB + hstepB + kstep, voffB);
        PG8_WAIT_V(6); PG8_BAR;
    } else {
    PG8_STAGE(PG8_SB(0, 0), cB, voffB); PG8_STAGE(PG8_SA(0, 0), cA, voffA); PG8_STAGE(PG8_SB(0, 1), cB + hstepB, voffB); PG8_STAGE(PG8_SA(0, 1), cA + hstepA, voffA);
    if (wr == 1) PG8_BAR;
    PG8_WAIT_V(4); PG8_BAR;
    PG8_STAGE(PG8_SB(1, 0), cB + kstep, voffB); PG8_STAGE(PG8_SA(1, 0), cA + kstep, voffA); PG8_STAGE(PG8_SB(1, 1), cB + hstepB + kstep, voffB);
    PG8_WAIT_V(6); PG8_BAR;
    }
    for (;;) {
        const bool has_next = S.next(ui + 1, nxt);
        const char* nA = has_next ? (const char*)g.A + (size_t)nxt.pm * tstepA + (size_t)nxt.pn * g.a_pn_off * 2 : cA; const char* nB = has_next ? (const char*)g.Bt + (size_t)nxt.pn * tstepB : cB;
        for (int t = 0; t < nt; t += 2) {
            const bool last = (t == nt - 2);
            const char* a1 = cA + (size_t)(t + 1) * kstep;
            const char* a2 = last ? nA : cA + (size_t)(t + 2) * kstep; const char* b2 = last ? nB : cB + (size_t)(t + 2) * kstep;
            const char* a3 = a2 + kstep; const char* b3 = b2 + kstep;
            if constexpr (Epi::MID) { if (t == 16 || t == 48) { if (wr == 0) PG8_BAR; E.mid(acc, cur, t, wr, wc, fr, fq); if (wr == 1) PG8_BAR; } }
            if constexpr (SP2) {
            PG8_LDB(B0, 0, 0); PG8_LDB(B1, 0, 1); PG8_SCHED; PG8_LDA(At, 0, 0); PG8_STAGE(PG8_SA(1, 1), a1 + hstepA, voffA);
            PG8_WAIT_V(8); PG8_WAIT_L(0); PG8_BAR; PG8_MMA(0, 0, At, B0); PG8_MMA(0, 1, At, B1); PG8_BAR; PG8_SCHED;
            PG8_LDA(At, 0, 1); PG8_STAGE(PG8_SB(0, 0), b2, voffB); PG8_STAGE(PG8_SB(0, 1), b2 + hstepB, voffB); PG8_STAGE(PG8_SA(0, 0), a2, voffA);
            PG8_WAIT_V(8); PG8_WAIT_L(0); PG8_BAR; PG8_MMA(1, 0, At, B0); PG8_MMA(1, 1, At, B1); PG8_BAR; PG8_SCHED;
            PG8_LDB(B0, 1, 0); PG8_LDB(B1, 1, 1); PG8_SCHED; PG8_LDA(At, 1, 0); PG8_STAGE(PG8_SA(0, 1), a2 + hstepA, voffA);
            PG8_WAIT_V(8); PG8_WAIT_L(0); PG8_BAR; PG8_MMA(0, 0, At, B0); PG8_MMA(0, 1, At, B1); PG8_BAR; PG8_SCHED;
            PG8_LDA(At, 1, 1); PG8_STAGE(PG8_SB(1, 0), b3, voffB); PG8_STAGE(PG8_SB(1, 1), b3 + hstepB, voffB); PG8_STAGE(PG8_SA(1, 0), a3, voffA);
            PG8_WAIT_V(8); PG8_WAIT_L(0); PG8_BAR; PG8_MMA(1, 0, At, B0); PG8_MMA(1, 1, At, B1); PG8_BAR; PG8_SCHED;
            } else {
            PG8_LDB(B0, 0, 0); PG8_SCHED; PG8_LDA(At, 0, 0); PG8_STAGE(PG8_SA(1, 1), a1 + hstepA, voffA);
            PG8_WAIT_L(8); PG8_BAR; PG8_WAIT_L(0); PG8_MMA(0, 0, At, B0); PG8_BAR; PG8_SCHED;
            PG8_LDB(B1, 0, 1); PG8_STAGE(PG8_SB(0, 0), b2, voffB);
            PG8_BAR; PG8_WAIT_L(0); PG8_MMA(0, 1, At, B1); PG8_BAR;
            PG8_LDA(At, 0, 1); PG8_STAGE(PG8_SA(0, 0), a2, voffA);
            PG8_BAR; PG8_WAIT_L(0); PG8_MMA(1, 0, At, B0); PG8_BAR; PG8_SCHED;
            PG8_STAGE(PG8_SB(0, 1), b2 + hstepB, voffB);
            PG8_WAIT_V(6); PG8_BAR; PG8_MMA(1, 1, At, B1); PG8_BAR;
            PG8_LDB(B0, 1, 0); PG8_SCHED; PG8_LDA(At, 1, 0); PG8_STAGE(PG8_SA(0, 1), a2 + hstepA, voffA);
            PG8_WAIT_L(8); PG8_BAR; PG8_WAIT_L(0); PG8_MMA(0, 0, At, B0); PG8_BAR; PG8_SCHED;
            PG8_LDB(B1, 1, 1); PG8_STAGE(PG8_SB(1, 0), b3, voffB);
            PG8_BAR; PG8_WAIT_L(0); PG8_MMA(0, 1, At, B1); PG8_BAR;
            PG8_LDA(At, 1, 1); PG8_STAGE(PG8_SA(1, 0), a3, voffA);
            PG8_BAR; PG8_WAIT_L(0); PG8_MMA(1, 0, At, B0); PG8_BAR; PG8_SCHED;
            PG8_STAGE(PG8_SB(1, 1), b3 + hstepB, voffB);
            PG8_WAIT_V(6); PG8_BAR; PG8_MMA(1, 1, At, B1); PG8_BAR;
            }
        }
        if constexpr (ALIGN_EPI) { if (wr == 0) PG8_BAR; }
        E(acc, cur, wr, wc, fr, fq);
        if (!has_next) break;
#pragma unroll
        for (int a = 0; a < 2; ++a)
#pragma unroll
            for (int b = 0; b < 2; ++b)
#pragma unroll
                for (int m = 0; m < 4; ++m)
#pragma unroll
                    for (int n = 0; n < 2; ++n) acc[a][b][m][n] = (f32x4){0.f, 0.f, 0.f, 0.f};
        cur = nxt; cA = nA; cB = nB; ++ui;
        if constexpr (ALIGN_EPI) { if (wr == 1) PG8_BAR; }
    }
    PG8_WAIT_V(0);
    if constexpr (!ALIGN_EPI) { if (wr == 0) PG8_BAR; }
    PG8_BAR;
#undef PG8_SA
#undef PG8_SB
#undef PG8_STAGE
#undef PG8_LDA
#undef PG8_LDB
#undef PG8_MMA
#undef PG8_WAIT_V
#undef PG8_WAIT_L
#undef PG8_BAR
#undef PG8_SCHED
}

typedef f32x4 AccT[2][2][4][2];

struct EpiInProj {
    static constexpr bool MID = false;
    bf16_t* proj; float* dt; const float* b_gate; bf16_t* gates; int pn_off; LAS const unsigned char* lbias;
    __device__ __forceinline__ void operator()(const AccT& acc, const Unit& u, int wr, int wc, int fr, int fq) const {
        fr = opq(fr); fq = opq(fq);
        const int row0 = u.pm * BM + wr * 64 + fr;
        const int upn = u.pn + pn_off;
        if (upn != 44) {
            const int col0 = upn * BM + wc * 32 + 8 * fq; const bool gate = upn >= 45, pgt = (upn >= 4) && (upn < 8), tl = gate || pgt;
            const int gk = gate ? (upn - 45) >> 3 : 3, gp = gate ? (upn - 45) & 7 : (upn & 3);
            const int tid = (wr * 4 + wc) * 64 + fq * 16 + fr;
            bf16_t* gbase = gates + ((size_t)((gk * 32 + u.pm) * 8 + gp) * 16 * 512 + tid) * 8;
            f32x4 bg[2][2];
#pragma unroll
            for (int bj = 0; bj < 2; ++bj)
#pragma unroll
                for (int n = 0; n < 2; ++n) { const u32x2 t = *(const LAS u32x2*)(lbias + ((gate ? (col0 + bj * HALF - 11520) : 0) + 4 * n) * 2); bg[bj][n] = (f32x4){bflo(t.x), bfhi(t.x), bflo(t.y), bfhi(t.y)}; }
#pragma unroll
            for (int ai = 0; ai < 2; ++ai)
#pragma unroll
                for (int m = 0; m < 4; ++m) { bf16_t* rowp = proj + (size_t)(row0 + ai * HALF + m * 16) * NPROJ + col0;
#pragma unroll
                    for (int bj = 0; bj < 2; ++bj) { f32x4 v0 = acc[ai][bj][m][0], v1 = acc[ai][bj][m][1];
#pragma unroll
                        for (int j = 0; j < 4; ++j) { const float s0 = sigmoidf_(v0[j] + bg[bj][0][j]), s1 = sigmoidf_(v1[j] + bg[bj][1][j]); v0[j] = gate ? s0 : v0[j]; v1[j] = gate ? s1 : v1[j]; }
                        u32x4 o; o.x = pk2(v0[0], v0[1]); o.y = pk2(v0[2], v0[3]); o.z = pk2(v1[0], v1[1]); o.w = pk2(v1[2], v1[3]);
                        bf16_t* dst = tl ? gbase + (size_t)(((ai * 4 + m) * 2 + bj) * 512) * 8 : rowp + bj * HALF;
                        *(u32x4*)dst = o; } }
        } else if (wc == 0) {
#pragma unroll
            for (int ai = 0; ai < 2; ++ai)
#pragma unroll
                for (int m = 0; m < 4; ++m) { float* rp = dt + (size_t)(row0 + ai * HALF + m * 16) * 32 + 8 * fq;
                    *(f32x4*)rp = acc[ai][0][m][0]; *(f32x4*)(rp + 4) = acc[ai][0][m][1]; }
        }
    }
};
struct EpiInProjU {
    static constexpr bool MID = false;
    bf16_t* proj; float* dt; bf16_t* gates; LAS const unsigned char* lbias; LAS const _Float16* lrstd;
    __device__ __forceinline__ void operator()(const AccT& acc, const Unit& u, int wr, int wc, int fr, int fq) const {
        fr = opq(fr); fq = opq(fq);
        const int row0 = u.pm * BM + wr * 64 + fr;
        const int tid = (wr * 4 + wc) * 64 + fq * 16 + fr;
        float rs[2][4];
#pragma unroll
        for (int ai = 0; ai < 2; ++ai)
#pragma unroll
            for (int m = 0; m < 4; ++m) rs[ai][m] = (float)lrstd[row0 + ai * HALF + m * 16];
        if (u.pn >= 45) {
            const int gpn = u.pn - 45, colb = gpn * BM + wc * 32 + 8 * fq;
            bf16_t* gbase = gates + ((size_t)(((gpn >> 3) * 32 + u.pm) * 8 + (gpn & 7)) * 16 * 512 + tid) * 8;
            f32x4 bg[2][2];
#pragma unroll
            for (int bj = 0; bj < 2; ++bj)
#pragma unroll
                for (int n = 0; n < 2; ++n) { const u32x2 t = *(const LAS u32x2*)(lbias + (colb + bj * HALF + 4 * n) * 2); bg[bj][n] = (f32x4){bflo(t.x), bfhi(t.x), bflo(t.y), bfhi(t.y)}; }
#pragma unroll
            for (int ai = 0; ai < 2; ++ai)
#pragma unroll
                for (int m = 0; m < 4; ++m)
#pragma unroll
                    for (int bj = 0; bj < 2; ++bj) { f32x4 v0 = acc[ai][bj][m][0], v1 = acc[ai][bj][m][1];
#pragma unroll
                        for (int j = 0; j < 4; ++j) { v0[j] = sigmoidf_(v0[j] * rs[ai][m] + bg[bj][0][j]); v1[j] = sigmoidf_(v1[j] * rs[ai][m] + bg[bj][1][j]); }
                        u32x4 o; o.x = pk2(v0[0], v0[1]); o.y = pk2(v0[2], v0[3]); o.z = pk2(v1[0], v1[1]); o.w = pk2(v1[2], v1[3]);
                        *(u32x4*)(gbase + (size_t)(((ai * 4 + m) * 2 + bj) * 512) * 8) = o; }
        } else if (u.pn < 44) {
            const int col0 = u.pn * BM + wc * 32 + 8 * fq; const bool tl = (u.pn >= 4) && (u.pn < 8);
            bf16_t* gbase = gates + ((size_t)((3 * 32 + u.pm) * 8 + (u.pn & 3)) * 16 * 512 + tid) * 8;
#pragma unroll
            for (int ai = 0; ai < 2; ++ai)
#pragma unroll
                for (int m = 0; m < 4; ++m) { bf16_t* rowp = proj + (size_t)(row0 + ai * HALF + m * 16) * NPROJ + col0;
#pragma unroll
                    for (int bj = 0; bj < 2; ++bj) { const f32x4 v0 = acc[ai][bj][m][0] * rs[ai][m], v1 = acc[ai][bj][m][1] * rs[ai][m];
                        u32x4 o; o.x = pk2(v0[0], v0[1]); o.y = pk2(v0[2], v0[3]); o.z = pk2(v1[0], v1[1]); o.w = pk2(v1[2], v1[3]);
                        bf16_t* dst = tl ? gbase + (size_t)(((ai * 4 + m) * 2 + bj) * 512) * 8 : rowp + bj * HALF;
                        *(u32x4*)dst = o; } }
        } else if (wc == 0) {
#pragma unroll
            for (int ai = 0; ai < 2; ++ai)
#pragma unroll
                for (int m = 0; m < 4; ++m) { float* rp = dt + (size_t)(row0 + ai * HALF + m * 16) * 32 + 8 * fq;
                    *(f32x4*)rp = acc[ai][0][m][0] * rs[ai][m]; *(f32x4*)(rp + 4) = acc[ai][0][m][1] * rs[ai][m]; }
        }
    }
};
struct EpiGrp {
    static constexpr bool MID = false;
    bf16_t* act; const bf16_t* gates; const float* scale;
    __device__ __forceinline__ void operator()(const AccT& acc, const Unit& u, int wr, int wc, int fr, int fq) const {
        fr = opq(fr); fq = opq(fq);
        const int row0 = u.pm * BM + wr * 64 + fr, col0 = u.pn * BM + wc * 32 + 8 * fq;
        const int tid = (wr * 4 + wc) * 64 + fq * 16 + fr;
        const bf16_t* pg = gates + ((size_t)((3 * 32 + u.pm) * 8 + u.pn) * 16 * 512 + tid) * 8;
        f32x4 sc[2][2];
#pragma unroll
        for (int bj = 0; bj < 2; ++bj)
#pragma unroll
            for (int n = 0; n < 2; ++n) sc[bj][n] = *(const f32x4*)(scale + col0 + bj * HALF + 4 * n);
#pragma unroll
        for (int ai = 0; ai < 2; ++ai)
#pragma unroll
            for (int m = 0; m < 4; ++m) { const size_t row = (size_t)(row0 + ai * HALF + m * 16); if ((m & 1) == 0) asm volatile("" ::: "memory");
#pragma unroll
                for (int bj = 0; bj < 2; ++bj) { const int col = col0 + bj * HALF;
                    float gf[8]; unpack8(*(const u32x4*)(pg + ((ai * 4 + m) * 2 + bj) * 512 * 8), gf);
                    float o[8];
#pragma unroll
                    for (int j = 0; j < 4; ++j) { o[j] = acc[ai][bj][m][0][j] * sc[bj][0][j] * siluf_(gf[j]); o[4 + j] = acc[ai][bj][m][1][j] * sc[bj][1][j] * siluf_(gf[4 + j]); }
                    *(u32x4*)(act + row * 4096 + col) = pack8(o); } }
    }
};
struct EpiBr {
    static constexpr bool MID = true;
    bf16_t* merged; const bf16_t* gates;
    __device__ __forceinline__ const bf16_t* gptr(const Unit& u, int k, int wr, int wc, int fr, int fq) const {
        const int tid = (wr * 4 + wc) * 64 + fq * 16 + fr;
        return gates + ((size_t)((k * 32 + u.pm) * 8 + u.pn) * 16 * 512 + tid) * 8;
    }
    __device__ __forceinline__ void mid(AccT& acc, const Unit& u, int t, int wr, int wc, int fr, int fq) const {
        fr = opq(fr); fq = opq(fq);
        const int ka = (t == 16) ? 0 : 1;
        const bf16_t* pa = gptr(u, ka, wr, wc, fr, fq); const bf16_t* pb = gptr(u, ka + 1, wr, wc, fr, fq);
#pragma unroll
        for (int ai = 0; ai < 2; ++ai)
#pragma unroll
            for (int m = 0; m < 4; ++m) { if (m == 0) asm volatile("" ::: "memory");
#pragma unroll
                for (int bj = 0; bj < 2; ++bj) { const int o = ((ai * 4 + m) * 2 + bj) * 512 * 8; float ga[8], gb[8]; unpack8(*(const u32x4*)(pa + o), ga); unpack8(*(const u32x4*)(pb + o), gb);
#pragma unroll
                    for (int j = 0; j < 4; ++j) { acc[ai][bj][m][0][j] *= ga[j] * __builtin_amdgcn_rcpf(fmaxf(gb[j], 1e-20f)); acc[ai][bj][m][1][j] *= ga[4 + j] * __builtin_amdgcn_rcpf(fmaxf(gb[4 + j], 1e-20f)); } } }
    }
    __device__ __forceinline__ void operator()(const AccT& acc, const Unit& u, int wr, int wc, int fr, int fq) const {
        fr = opq(fr); fq = opq(fq);
        const int row0 = u.pm * BM + wr * 64 + fr, col0 = u.pn * BM + wc * 32 + 8 * fq;
        const bf16_t* pg = gptr(u, 2, wr, wc, fr, fq);
#pragma unroll
        for (int ai = 0; ai < 2; ++ai)
#pragma unroll
            for (int m = 0; m < 4; ++m) { const size_t row = (size_t)(row0 + ai * HALF + m * 16); if (m == 0) asm volatile("" ::: "memory");
#pragma unroll
                for (int bj = 0; bj < 2; ++bj) { const int col = col0 + bj * HALF; float g2[8]; unpack8(*(const u32x4*)(pg + ((ai * 4 + m) * 2 + bj) * 512 * 8), g2);
                    float o[8];
#pragma unroll
                    for (int j = 0; j < 4; ++j) { o[j] = acc[ai][bj][m][0][j] * g2[j]; o[4 + j] = acc[ai][bj][m][1][j] * g2[4 + j]; }
                    *(u32x4*)(merged + row * DM + col) = pack8(o); } }
    }
};
struct EpiOut {
    static constexpr bool MID = false;
    const float* xin; float* xout; const float* nw_next; bf16_t* hout; float* rowsq;
    __device__ __forceinline__ void operator()(const AccT& acc, const Unit& u, int wr, int wc, int fr, int fq) const {
        fr = opq(fr); fq = opq(fq);
        const int row0 = u.pm * BM + wr * 64 + fr, col0 = u.pn * BM + wc * 32 + 8 * fq;
        const bool fuse = nw_next != nullptr;
        f32x4 nw[2][2];
#pragma unroll
        for (int bj = 0; bj < 2; ++bj)
#pragma unroll
            for (int n = 0; n < 2; ++n) nw[bj][n] = fuse ? *(const f32x4*)(nw_next + col0 + bj * HALF + 4 * n) : (f32x4){0.f, 0.f, 0.f, 0.f};
#pragma unroll
        for (int ai = 0; ai < 2; ++ai)
#pragma unroll
            for (int m = 0; m < 4; ++m) { const int row = row0 + ai * HALF + m * 16; const size_t off = (size_t)row * DM + col0; float ssq = 0.f;
                if ((m & 1) == 0) asm volatile("" ::: "memory");
#pragma unroll
                for (int bj = 0; bj < 2; ++bj) {
                    const f32x4 x0 = *(const f32x4*)(xin + off + bj * HALF), x1 = *(const f32x4*)(xin + off + bj * HALF + 4);
                    const f32x4 y0 = x0 + acc[ai][bj][m][0], y1 = x1 + acc[ai][bj][m][1];
                    *(f32x4*)(xout + off + bj * HALF) = y0; *(f32x4*)(xout + off + bj * HALF + 4) = y1;
                    if (fuse) {
                        ssq += (y0[0] * y0[0] + y0[1] * y0[1]) + (y0[2] * y0[2] + y0[3] * y0[3]) + (y1[0] * y1[0] + y1[1] * y1[1]) + (y1[2] * y1[2] + y1[3] * y1[3]);
                        const f32x4 h0 = y0 * nw[bj][0], h1 = y1 * nw[bj][1];
                        u32x4 o; o.x = pk2(h0[0], h0[1]); o.y = pk2(h0[2], h0[3]); o.z = pk2(h1[0], h1[1]); o.w = pk2(h1[2], h1[3]);
                        *(u32x4*)(hout + off + bj * HALF) = o; } }
                if (fuse) { ssq += __shfl_xor(ssq, 16); ssq += __shfl_xor(ssq, 32); if (fq == 0) atomicAdd(rowsq + row, ssq); } }
    }
};

__device__ __forceinline__ void cvt_matrix(const float* src, int K, int N, bf16_t* dst, int ld_dst, int dst_koff, int mode, LAS float* scr, int lane, int gw, int ngw) {
    const int nblk = N / 32, nitems = (K / 64) * nblk;
    for (int item = gw; item < nitems; item += ngw) {
        const int kb = item / nblk, nb = item - kb * nblk, k0 = 64 * kb, n0 = 32 * nb;
        const float* sp = src + (size_t)(k0 + (lane >> 5)) * N + n0 + (lane & 31);
        float v[32];
#pragma unroll
        for (int i = 0; i < 32; ++i) v[i] = __builtin_nontemporal_load(sp + (size_t)(2 * i) * N);
#pragma unroll
        for (int i = 0; i < 32; ++i) scr[(2 * i + (lane >> 5)) * 33 + (lane & 31)] = v[i];
        asm volatile("s_waitcnt lgkmcnt(0)" ::: "memory");
        int drow0 = n0;
        if (mode == 1) drow0 = n0 < 7168 ? n0 : (n0 < 7200 ? 11264 : (n0 < 11296 ? n0 - 32 : n0 + 224));
        const int c = lane & 7;
#pragma unroll
        for (int j = 0; j < 4; ++j) { const int n = (lane >> 3) + 8 * j; float f[8];
#pragma unroll
            for (int i = 0; i < 8; ++i) f[i] = scr[(8 * c + i) * 33 + n];
            *(u32x4*)(dst + (size_t)(drow0 + n) * ld_dst + dst_koff + k0 + 8 * c) = pack8(f); }
        asm volatile("s_waitcnt lgkmcnt(0)" ::: "memory");
    }
}
__device__ __forceinline__ void phase_convert(const Params& P, LAS unsigned char* lds) {
    const int tid_ = opq(threadIdx.x), lane = tid_ & 63, wave = tid_ >> 6;
    LAS float* scr = (LAS float*)(lds + wave * 8448);
    const int gw = blockIdx.x * 8 + wave, ngw = gridDim.x * 8;
#pragma unroll 1
    for (int L = 0; L < 4; ++L) {
        cvt_matrix(P.w_in + (size_t)L * DM * NIN_SRC, DM, NIN_SRC, P.bt_in() + (size_t)L * NIN_PAD * DM, DM, 0, 1, scr, lane, gw, ngw);
#pragma unroll 1
        for (int g = 0; g < 4; ++g) cvt_matrix(P.pool_w + ((size_t)L * 4 + g) * 65536, 256, 256, P.bt_grp() + ((size_t)L * 4 + g) * 65536, 256, 0, 0, scr, lane, gw, ngw);
        cvt_matrix(P.w_br_pool + (size_t)L * 1024 * DM, 1024, DM, P.bt_br() + (size_t)L * DM * 4096, 4096, 0, 0, scr, lane, gw, ngw);
        cvt_matrix(P.w_br_ssm + (size_t)L * 2048 * DM, 2048, DM, P.bt_br() + (size_t)L * DM * 4096, 4096, 1024, 0, scr, lane, gw, ngw);
        cvt_matrix(P.w_br_conv + (size_t)L * 1024 * DM, 1024, DM, P.bt_br() + (size_t)L * DM * 4096, 4096, 3072, 0, scr, lane, gw, ngw);
        cvt_matrix(P.w_out + (size_t)L * DM * DM, DM, DM, P.bt_out() + (size_t)L * DM * DM, DM, 0, 0, scr, lane, gw, ngw);
        u32x4* z = (u32x4*)(P.bt_in() + (size_t)L * NIN_PAD * DM + (size_t)11296 * DM);
        for (int i = blockIdx.x * 512 + tid_; i < 224 * 256; i += gridDim.x * 512) z[i] = (u32x4){0u, 0u, 0u, 0u};
    }
}

__device__ __forceinline__ void phase_rmsnorm(const float* xin, const float* w, bf16_t* hout, float* fout, float* rowsq_out = nullptr) {
    const int tid_ = opq(threadIdx.x); const int lane = tid_ & 63, wave = tid_ >> 6;
    for (int row = blockIdx.x * 8 + wave; row < M_TOK; row += gridDim.x * 8) {
        const f32x4* xr = (const f32x4*)(xin + (size_t)row * DM) + lane;
        f32x4 v[8]; float s = 0.f;
#pragma unroll
        for (int j = 0; j < 8; ++j) { v[j] = xr[64 * j]; s += (v[j][0] * v[j][0] + v[j][1] * v[j][1]) + (v[j][2] * v[j][2] + v[j][3] * v[j][3]); }
        s = wave_sum(s);
        const float rstd = rowsq_out ? 1.f : rsqrtf(s * (1.f / DM) + EPS);
        if (rowsq_out && lane == 0) rowsq_out[row] = s;
#pragma unroll
        for (int j = 0; j < 8; ++j) { const f32x4 wv = ((const f32x4*)w)[lane + 64 * j]; const f32x4 o = v[j] * rstd * wv;
            if (hout) { u32x2 pk; pk.x = pk2(o[0], o[1]); pk.y = pk2(o[2], o[3]); *(u32x2*)(hout + (size_t)row * DM + (lane + 64 * j) * 4) = pk; }
            else *(f32x4*)(fout + (size_t)row * DM + (lane + 64 * j) * 4) = o; }
    }
}

__device__ __forceinline__ void phase_prep(const Params& P, int L) {
    const int gtid = blockIdx.x * 512 + opq(threadIdx.x), gsz = gridDim.x * 512;
    const u32x4 zero4 = (u32x4){0u, 0u, 0u, 0u};
    for (int i = gtid; i < M_TOK; i += gsz) P.rowsq()[i] = 0.f;
    for (int it = gtid; it < 512 * 128; it += gsz) {
        const int ch8 = it & 127, blk = it >> 7, g = ch8 >> 5, win = 2 << g, t0 = blk * 16, pos0 = t0 & 4095;
        const bf16_t* up = P.proj() + (size_t)t0 * NPROJ + ch8 * 8;
        float s[8];
#pragma unroll
        for (int i = 0; i < 8; ++i) s[i] = 0.f;
        const int nh = (win - 1) < pos0 ? (win - 1) : pos0;
        for (int i = 1; i <= nh; ++i) { float f[8]; unpack8(*(const u32x4*)(up - (ptrdiff_t)i * NPROJ), f);
#pragma unroll
            for (int k = 0; k < 8; ++k) s[k] += f[k]; }
#pragma unroll 1
        for (int jb = 0; jb < 16; jb += 4) {
            u32x4 cu[4], ol[4];
#pragma unroll
            for (int r = 0; r < 4; ++r) cu[r] = *(const u32x4*)(up + (ptrdiff_t)(jb + r) * NPROJ);
#pragma unroll
            for (int r = 0; r < 4; ++r) { const int jo = jb + r - win + 1; ol[r] = zero4; if (pos0 + jo >= 0) ol[r] = *(const u32x4*)(up + (ptrdiff_t)jo * NPROJ); }
#pragma unroll
            for (int r = 0; r < 4; ++r) {
                float cur[8], o[8], d[8]; unpack8(cu[r], cur); unpack8(ol[r], o);
                const int pos = pos0 + jb + r; const int cnt = (pos + 1) < win ? (pos + 1) : win; const float inv = 1.f / (float)cnt;
#pragma unroll
                for (int k = 0; k < 8; ++k) { s[k] += cur[k]; d[k] = s[k] * inv - cur[k]; s[k] -= o[k]; }
                *(u32x4*)(P.dpool() + (size_t)(t0 + jb + r) * 1024 + ch8 * 8) = pack8(d);
            }
        }
    }
    for (int it = gtid; it < 512 * 384; it += gsz) {
        const int ch8 = it % 384, blk = it / 384, ch = ch8 * 8, t0 = blk * 16, pos0 = t0 & 4095;
        const float* cw = P.ssm_conv_w + (size_t)L * 4 * 3072 + ch; const float* cb = P.ssm_conv_b + (size_t)L * 3072 + ch;
        float w0[8], w1[8], w2[8], w3[8], bb[8];
#pragma unroll
        for (int k = 0; k < 8; ++k) { w0[k] = cw[k]; w1[k] = cw[3072 + k]; w2[k] = cw[2 * 3072 + k]; w3[k] = cw[3 * 3072 + k]; bb[k] = cb[k]; }
        const bf16_t* src = P.proj() + (size_t)t0 * NPROJ + 4096 + ch;
        float x1[8], x2[8], x3[8];
#pragma unroll
        for (int k = 0; k < 8; ++k) { x1[k] = 0.f; x2[k] = 0.f; x3[k] = 0.f; }
        if (pos0 >= 3) { unpack8(*(const u32x4*)(src - (ptrdiff_t)1 * NPROJ), x1); unpack8(*(const u32x4*)(src - (ptrdiff_t)2 * NPROJ), x2); unpack8(*(const u32x4*)(src - (ptrdiff_t)3 * NPROJ), x3); }
#pragma unroll 1
        for (int jb = 0; jb < 16; jb += 8) {
            u32x4 cu[8];
#pragma unroll
            for (int r = 0; r < 8; ++r) cu[r] = *(const u32x4*)(src + (ptrdiff_t)(jb + r) * NPROJ);
#pragma unroll
            for (int r = 0; r < 8; ++r) {
                float cur[8], o[8]; unpack8(cu[r], cur);
#pragma unroll
                for (int k = 0; k < 8; ++k) { const float a = bb[k] + w0[k] * x3[k] + w1[k] * x2[k] + w2[k] * x1[k] + w3[k] * cur[k]; o[k] = siluf_(a); x3[k] = x2[k]; x2[k] = x1[k]; x1[k] = cur[k]; }
                *(u32x4*)(P.xbc() + (size_t)(t0 + jb + r) * 3072 + ch) = pack8(o);
            }
        }
    }
    for (int it = gtid; it < 512 * 128; it += gsz) {
        const int ch8 = it & 127, blk = it >> 7, ch = ch8 * 8, t0 = blk * 16, pos0 = t0 & 4095;
        const float* cw = P.sc_conv_w + (size_t)L * 3 * 1024 + ch;
        float w0[8], w1[8], w2[8];
#pragma unroll
        for (int k = 0; k < 8; ++k) { w0[k] = cw[k]; w1[k] = cw[1024 + k]; w2[k] = cw[2048 + k]; }
        const bf16_t* base = P.proj() + (size_t)t0 * NPROJ + 7168 + ch;
        float m1[8], m2[8];
#pragma unroll
        for (int k = 0; k < 8; ++k) { m1[k] = 0.f; m2[k] = 0.f; }
        if (pos0 >= 2) { float a[8], b[8], c[8], d[8];
            unpack8(*(const u32x4*)(base - (ptrdiff_t)1 * NPROJ + 1024), a); unpack8(*(const u32x4*)(base - (ptrdiff_t)1 * NPROJ + 2048), b);
            unpack8(*(const u32x4*)(base - (ptrdiff_t)2 * NPROJ + 1024), c); unpack8(*(const u32x4*)(base - (ptrdiff_t)2 * NPROJ + 2048), d);
#pragma unroll
            for (int k = 0; k < 8; ++k) { m1[k] = a[k] * b[k]; m2[k] = c[k] * d[k]; } }
#pragma unroll 1
        for (int jb = 0; jb < 16; jb += 4) {
            u32x4 rb[4], rc[4], rv[4], rg[4];
#pragma unroll
            for (int r = 0; r < 4; ++r) { const bf16_t* rp = base + (ptrdiff_t)(jb + r) * NPROJ;
                rb[r] = *(const u32x4*)(rp); rc[r] = *(const u32x4*)(rp + 1024); rv[r] = *(const u32x4*)(rp + 2048); rg[r] = *(const u32x4*)(rp + 3072); }
#pragma unroll
            for (int r = 0; r < 4; ++r) {
                float vb[8], vc[8], vv[8], vg[8], o[8];
                unpack8(rb[r], vb); unpack8(rc[r], vc); unpack8(rv[r], vv); unpack8(rg[r], vg);
#pragma unroll
                for (int k = 0; k < 8; ++k) { const float mc = vc[k] * vv[k]; const float cv = w0[k] * m2[k] + w1[k] * m1[k] + w2[k] * mc; o[k] = vb[k] * cv * siluf_(vg[k]); m2[k] = m1[k]; m1[k] = mc; }
                *(u32x4*)(P.act() + (size_t)(t0 + jb + r) * 4096 + 3072 + ch) = pack8(o);
            }
        }
    }
}

__device__ __forceinline__ void ssd_dt_scan(const Params& P, int L, int m0, int g, int bc, LAS float* acum, LAS float* aux, int mode) {
    const int tid_ = opq(threadIdx.x); const int lane = tid_ & 63, e = tid_ >> 6, h = g * 8 + e;
    const float bias = P.ssm_dt_bias[L * 32 + h], a = -expf(P.ssm_a_log[L * 32 + h]);
    const float d0 = softplusf_(P.dt()[(size_t)(m0 + lane) * 32 + h] + bias), d1 = softplusf_(P.dt()[(size_t)(m0 + 64 + lane) * 32 + h] + bias);
    const float c0 = wave_scan_incl(d0 * a, lane); const float tot0 = __shfl(c0, 63);
    const float c1 = wave_scan_incl(d1 * a, lane) + tot0; const float alast = __shfl(c1, 63);
    acum[e * 128 + lane] = c0; acum[e * 128 + 64 + lane] = c1;
    if (mode == 0) { aux[e * 128 + lane] = d0 * __expf(alast - c0); aux[e * 128 + 64 + lane] = d1 * __expf(alast - c1);
        if (lane == 0) P.decay()[bc * 32 + h] = __expf(alast); }
    else { aux[e * 128 + lane] = d0; aux[e * 128 + 64 + lane] = d1; }
}

__device__ __forceinline__ void ssd_states_unit(const Params& P, int L, int unit, LAS unsigned char* lds) {
    const int tid = opq(threadIdx.x), lane = tid & 63, w = tid >> 6, fr = lane & 15, fq = lane >> 4, q = fr >> 2, pp = lane & 3;
    const int g = unit & 3, bc = unit >> 2, m0 = bc * 128;
    LAS unsigned char* Bm = lds;
    LAS unsigned char* XW = lds + 36864;
    LAS float* acum = (LAS float*)(lds + 102400); LAS float* wl = (LAS float*)(lds + 106496);
    ssd_dt_scan(P, L, m0, g, bc, acum, wl, 0);
#pragma unroll
    for (int it = 0; it < 4; ++it) { const int idx = it * 512 + tid, row = idx >> 4, c = idx & 15;
        *(LAS u32x4*)(Bm + row * 288 + c * 16) = *(const u32x4*)(P.xbc() + (size_t)(m0 + row) * 3072 + 2048 + g * 128 + c * 8); }
    __syncthreads();
#pragma unroll 1
    for (int pass = 0; pass < 2; ++pass) {
#pragma unroll
        for (int it = 0; it < 8; ++it) { const int idx = it * 512 + tid, row = idx >> 5, c = idx & 31, hh = c >> 3, p8 = (c & 7) * 8;
            float f[8]; unpack8(*(const u32x4*)(P.xbc() + (size_t)(m0 + row) * 3072 + g * 512 + (pass * 4 + hh) * 64 + p8), f);
            const float wv = wl[(pass * 4 + hh) * 128 + row];
#pragma unroll
            for (int k = 0; k < 8; ++k) f[k] *= wv;
            *(LAS u32x4*)(XW + hh * 16384 + row * 128 + p8 * 2) = pack8(f); }
        __syncthreads();
        const int hh = w & 3, ph = w >> 2;
        f32x4 acc[2][8];
#pragma unroll
        for (int a = 0; a < 2; ++a)
#pragma unroll
            for (int b = 0; b < 8; ++b) acc[a][b] = (f32x4){0.f, 0.f, 0.f, 0.f};
        const unsigned xbase = lds_addr(XW) + hh * 16384 + (8 * fq + q) * 128 + (ph * 32 + 4 * pp) * 2;
        const unsigned bbase = lds_addr(Bm) + (8 * fq + q) * 288 + (4 * pp) * 2;
#pragma unroll
        for (int ks = 0; ks < 4; ++ks) {
            bf16x8 xf0, xf1; tr_frag2<512, 32>(xbase + ks * 4096, xf0, xf1);
#pragma unroll
            for (int nh = 0; nh < 2; ++nh) { bf16x8 bf[4]; tr_frag4<1152, 32>(bbase + ks * 9216 + nh * 128, bf);
#pragma unroll
                for (int nn = 0; nn < 4; ++nn) { const int nt = nh * 4 + nn;
                    acc[0][nt] = __builtin_amdgcn_mfma_f32_16x16x32_bf16(bf[nn], xf0, acc[0][nt], 0, 0, 0);
                    acc[1][nt] = __builtin_amdgcn_mfma_f32_16x16x32_bf16(bf[nn], xf1, acc[1][nt], 0, 0, 0); } }
        }
        const int h = g * 8 + pass * 4 + hh; float* sp = P.states() + (size_t)(bc * 32 + h) * 8192;
#pragma unroll
        for (int pt = 0; pt < 2; ++pt)
#pragma unroll
            for (int nt = 0; nt < 8; ++nt) *(f32x4*)(sp + ((2 * ph + pt) * 16 + fr) * 128 + nt * 16 + 4 * fq) = acc[pt][nt];
        __syncthreads();
    }
}

__device__ __forceinline__ void phase_scan(const Params& P, int worker, int nworkers) {
    const int gtid = worker * 512 + opq(threadIdx.x), gsz = nworkers * 512;
    for (int it = gtid; it < 2 * 32 * 2048; it += gsz) {
        const int e4 = it & 2047, bh = it >> 11, b = bh >> 5, h = bh & 31;
        f32x4 carry = (f32x4){0.f, 0.f, 0.f, 0.f};
#pragma unroll 1
        for (int cb = 0; cb < 32; cb += 8) {
            f32x4 st[8]; float dec[8];
#pragma unroll
            for (int k = 0; k < 8; ++k) { const size_t idx = (size_t)((b * 32 + cb + k) * 32 + h); st[k] = *(const f32x4*)(P.states() + idx * 8192 + e4 * 4); dec[k] = P.decay()[idx]; }
            __builtin_amdgcn_sched_barrier(0);
#pragma unroll
            for (int k = 0; k < 8; ++k) { const size_t idx = (size_t)((b * 32 + cb + k) * 32 + h);
                u32x2 o; o.x = pk2(carry[0], carry[1]); o.y = pk2(carry[2], carry[3]);
                *(u32x2*)(P.prev() + idx * 8192 + e4 * 4) = o;
                carry = carry * dec[k] + st[k]; }
        }
    }
}

__device__ __forceinline__ void ssd_out_unit(const Params& P, int L, int unit, LAS unsigned char* lds) {
    const int tid = opq(threadIdx.x), lane = tid & 63, w = tid >> 6, fr0 = lane & 15, fq0 = lane >> 4;
    const int g = unit & 3, bc = unit >> 2, m0 = bc * 128;
    LAS unsigned char* Cm = lds; LAS unsigned char* Bm = lds + 34816;
    LAS unsigned char* X = lds;
    LAS float* acum = (LAS float*)(lds + 131072); LAS float* dts = (LAS float*)(lds + 135168); LAS float* red = (LAS float*)(lds + 139264);
    ssd_dt_scan(P, L, m0, g, bc, acum, dts, 1);
#pragma unroll
    for (int it = 0; it < 4; ++it) { const int idx = it * 512 + tid, row = idx >> 4, c = idx & 15;
        const bf16_t* rp = P.xbc() + (size_t)(m0 + row) * 3072 + 2048 + g * 128 + c * 8;
        *(LAS u32x4*)(Bm + row * 272 + c * 16) = *(const u32x4*)(rp); *(LAS u32x4*)(Cm + row * 272 + c * 16) = *(const u32x4*)(rp + 512); }
    __syncthreads();
    const int pair = w & 3, hq = w >> 2, lt0 = pair, lt1 = 7 - pair;
    f32x4 cb0[4], cb1[8];
#pragma unroll
    for (int i = 0; i < 4; ++i) cb0[i] = (f32x4){0.f, 0.f, 0.f, 0.f};
#pragma unroll
    for (int i = 0; i < 8; ++i) cb1[i] = (f32x4){0.f, 0.f, 0.f, 0.f};
    bf16x8 cfr[2][4];
    {
        const LAS unsigned char* cr0 = Cm + (lt0 * 16 + fr0) * 272 + fq0 * 16; const LAS unsigned char* cr1 = Cm + (lt1 * 16 + fr0) * 272 + fq0 * 16;
#pragma unroll
        for (int ks = 0; ks < 4; ++ks) { cfr[0][ks] = *(const LAS bf16x8*)(cr0 + ks * 64); cfr[1][ks] = *(const LAS bf16x8*)(cr1 + ks * 64); }
    }
    const LAS unsigned char* br = Bm + fr0 * 272 + fq0 * 16;
#pragma unroll
    for (int ks = 0; ks < 4; ++ks) {
#pragma unroll
        for (int S = 0; S < 8; ++S) { if (S <= lt1) { const bf16x8 bfr = *(const LAS bf16x8*)(br + S * 16 * 272 + ks * 64);
                cb1[S] = __builtin_amdgcn_mfma_f32_16x16x32_bf16(bfr, cfr[1][ks], cb1[S], 0, 0, 0);
                if (S < 4) { if (S <= lt0) cb0[S < 4 ? S : 0] = __builtin_amdgcn_mfma_f32_16x16x32_bf16(bfr, cfr[0][ks], cb0[S < 4 ? S : 0], 0, 0, 0); } } }
    }
    __syncthreads();
#pragma unroll
    for (int it = 0; it < 16; ++it) { const int idx = it * 512 + tid, row = idx >> 6, c = idx & 63, e = c >> 3, p8 = (c & 7) * 8;
        *(LAS u32x4*)(X + e * 16384 + row * 128 + p8 * 2) = *(const u32x4*)(P.xbc() + (size_t)(m0 + row) * 3072 + g * 512 + c * 8); }
    __syncthreads();
#pragma unroll
    for (int lo = 0; lo < 2; ++lo) {
        const int li = 1 - lo;
        const int lane_ = opq(lane), fr = lane_ & 15, fq = lane_ >> 4, q = fr >> 2, pp = lane_ & 3;
        const int lt = li ? lt1 : lt0, l = lt * 16 + fr; const size_t m = (size_t)(m0 + l);
        f32x4 acc[4][4];
#pragma unroll
        for (int i = 0; i < 4; ++i)
#pragma unroll
            for (int pt = 0; pt < 4; ++pt) acc[i][pt] = (f32x4){0.f, 0.f, 0.f, 0.f};
#pragma unroll
        for (int i = 0; i < 4; ++i) { const int e = hq * 4 + i, h = g * 8 + e; const bf16_t* pv = P.prev() + (size_t)(bc * 32 + h) * 8192;
            bf16x8 pf[16];
            asm volatile("" ::: "memory");
#pragma unroll
            for (int ks = 0; ks < 4; ++ks)
#pragma unroll
                for (int pt = 0; pt < 4; ++pt) pf[ks * 4 + pt] = *(const bf16x8*)(pv + (32 * (pt >> 1) + 8 * (fr >> 2) + 4 * (pt & 1) + (fr & 3)) * 128 + ks * 32 + fq * 8);
            __builtin_amdgcn_sched_barrier(0);
#pragma unroll
            for (int ks = 0; ks < 4; ++ks)
#pragma unroll
                for (int pt = 0; pt < 4; ++pt) acc[i][pt] = __builtin_amdgcn_mfma_f32_16x16x32_bf16(pf[ks * 4 + pt], cfr[li][ks], acc[i][pt], 0, 0, 0);
            const float sc = __expf(acum[e * 128 + l]);
#pragma unroll
            for (int pt = 0; pt < 4; ++pt) acc[i][pt] *= sc;
        }
#pragma unroll
        for (int i = 0; i < 4; ++i) { const int e = hq * 4 + i;
            const unsigned xb = lds_addr(X) + e * 16384 + (4 * fq + q) * 128 + (8 * pp) * 2;
            const float al = acum[e * 128 + l];
#pragma unroll
            for (int u = 0; u < (li ? 4 : 2); ++u) { if (2 * u <= lt) {
                    float gv[8];
#pragma unroll
                    for (int t = 0; t < 2; ++t) { const int S = 2 * u + t; const f32x4 cbt = li ? cb1[S] : cb0[S < 4 ? S : 0];
                        const f32x4 as = *(const LAS f32x4*)(acum + e * 128 + S * 16 + 4 * fq), ds = *(const LAS f32x4*)(dts + e * 128 + S * 16 + 4 * fq);
#pragma unroll
                        for (int j = 0; j < 4; ++j) { const int s = S * 16 + 4 * fq + j; const float v = cbt[j] * __expf(al - as[j]) * ds[j]; gv[4 * t + j] = (s <= l) ? v : 0.f; } }
                    const bf16x8 gf = __builtin_bit_cast(bf16x8, pack8(gv));
                    bf16x8 xf[4]; tr_frag4o<2048, 8, 64, 72>(xb + u * 4096, xf);
#pragma unroll
                    for (int pt = 0; pt < 4; ++pt) acc[i][pt] = __builtin_amdgcn_mfma_f32_16x16x32_bf16(xf[pt], gf, acc[i][pt], 0, 0, 0); } }
        }
        float ss = 0.f;
        u32x4 zz[8];
        asm volatile("" ::: "memory");
#pragma unroll
        for (int i = 0; i < 4; ++i)
#pragma unroll
            for (int k = 0; k < 2; ++k) zz[i * 2 + k] = *(const u32x4*)(P.proj() + m * NPROJ + 2048 + g * 512 + (hq * 4 + i) * 64 + 32 * k + 8 * fq);
        __builtin_amdgcn_sched_barrier(0);
#pragma unroll
        for (int i = 0; i < 4; ++i) { const int e = hq * 4 + i, h = g * 8 + e; const float Dk = P.ssm_d[L * 32 + h];
#pragma unroll
            for (int k = 0; k < 2; ++k) { const int p = 32 * k + 8 * fq;
                float xf_[8], zf[8]; unpack8(*(const LAS u32x4*)(X + e * 16384 + l * 128 + p * 2), xf_); unpack8(zz[i * 2 + k], zf);
#pragma unroll
                for (int j = 0; j < 4; ++j) { const float v0 = (acc[i][2 * k][j] + xf_[j] * Dk) * siluf_(zf[j]), v1 = (acc[i][2 * k + 1][j] + xf_[4 + j] * Dk) * siluf_(zf[4 + j]);
                    acc[i][2 * k][j] = v0; acc[i][2 * k + 1][j] = v1; ss += v0 * v0 + v1 * v1; } } }
        ss += __shfl_xor(ss, 16); ss += __shfl_xor(ss, 32);
        if (fq == 0) red[hq * 128 + l] = ss;
        __syncthreads();
        const float r = rsqrtf((red[l] + red[128 + l]) * (1.f / 512.f) + EPS);
#pragma unroll
        for (int i = 0; i < 4; ++i) { const int e = hq * 4 + i; if ((i & 1) == 0) asm volatile("" ::: "memory");
#pragma unroll
            for (int k = 0; k < 2; ++k) { const int ch = g * 512 + e * 64 + 32 * k + 8 * fq;
                const f32x4 nw0 = *(const f32x4*)(P.ssm_norm_w + (size_t)L * 2048 + ch), nw1 = *(const f32x4*)(P.ssm_norm_w + (size_t)L * 2048 + ch + 4);
                const f32x4 va = acc[i][2 * k], vb = acc[i][2 * k + 1];
                u32x4 o; o.x = pk2(va[0] * r * nw0[0], va[1] * r * nw0[1]); o.y = pk2(va[2] * r * nw0[2], va[3] * r * nw0[3]);
                o.z = pk2(vb[0] * r * nw1[0], vb[1] * r * nw1[1]); o.w = pk2(vb[2] * r * nw1[2], vb[3] * r * nw1[3]);
                *(u32x4*)(P.act() + m * 4096 + 1024 + ch) = o; } }
    }
    __syncthreads();
}


#define XB_TMO      128
#define XB_XCNT(j)  (256  + 64 * (j))
#define XB_XSUB(j)  (1280 + 64 * (j))
#define XB_XGEN(j)  (2304 + 64 * (j))
#define XB_TOP      3328
#define XB_TOPGEN   3392
#define XCD_BAR_WORDS 3456
#define XB_SPIN_CAP (1u << 18)
__device__ __forceinline__ unsigned xb_ld(unsigned* p)              { return __hip_atomic_load(p, __ATOMIC_RELAXED, __HIP_MEMORY_SCOPE_AGENT); }
__device__ __forceinline__ unsigned xb_add(unsigned* p, unsigned v) { return __hip_atomic_fetch_add(p, v, __ATOMIC_RELAXED, __HIP_MEMORY_SCOPE_AGENT); }
__device__ __forceinline__ unsigned xb_xcc_id() { return (unsigned)__builtin_amdgcn_s_getreg((3 << 11) | 20) & 0xFu; }
#define XB_SPIN(cond, bar) do { unsigned _sp = 0; while (cond) { __builtin_amdgcn_s_sleep(1); \
    if ((++_sp & 255u) == 0u) { if (xb_ld(&(bar)[XB_TMO])) break; if (_sp > XB_SPIN_CAP) { atomicAdd(&(bar)[XB_TMO], 1u); break; } } } } while (0)
struct XcdBarrier { unsigned* bar; unsigned x; volatile LAS unsigned* st; };
__device__ __forceinline__ XcdBarrier xcd_barrier_post(unsigned* bar, volatile LAS unsigned* st) {
    XcdBarrier b; b.bar = bar; b.x = xb_xcc_id(); b.st = st;
    if (threadIdx.x == 0) (void)xb_add(&bar[XB_XCNT(b.x)], 1u);
    return b;
}
__device__ __forceinline__ void xcd_barrier_complete(unsigned* bar, unsigned x, unsigned& nloc, unsigned& nx) {
    const unsigned G = gridDim.x * gridDim.y * gridDim.z;
    unsigned sum, cnt, mine, sp = 0u;
    for (;;) {
        sum = 0u; cnt = 0u; mine = 0u;
#pragma unroll
        for (unsigned j = 0; j < 16; ++j) { const unsigned c = xb_ld(&bar[XB_XCNT(j)]); sum += c; cnt += (c > 0u) ? 1u : 0u; mine = (j == x) ? c : mine; }
        if (sum == G) break;
        __builtin_amdgcn_s_sleep(1);
        if ((++sp & 255u) == 0u) { if (xb_ld(&bar[XB_TMO])) break; if (sp > XB_SPIN_CAP) { atomicAdd(&bar[XB_TMO], 1u); break; } }
    }
    nloc = mine > 0u ? mine : 1u; nx = cnt > 0u ? cnt : 1u;
}
__device__ __forceinline__ void xcd_barrier(const XcdBarrier& b) {
    asm volatile("s_waitcnt vmcnt(0)" ::: "memory");
    __syncthreads();
    if (threadIdx.x == 0) {
        unsigned* bar = b.bar;
        __builtin_amdgcn_s_waitcnt(0);
        unsigned nloc = b.st[0], nx = b.st[1];
        if (nloc == 0u) { xcd_barrier_complete(bar, b.x, nloc, nx); b.st[0] = nloc; b.st[1] = nx; }
        const unsigned old = xb_add(&bar[XB_XSUB(b.x)], 1u);
        const unsigned gen = old / nloc;
        if (old + 1u == (gen + 1u) * nloc) {
            __builtin_amdgcn_fence(__ATOMIC_RELEASE, "agent");
            asm volatile("s_waitcnt vmcnt(0)" ::: "memory");
            const unsigned og = xb_add(&bar[XB_TOP], 1u);
            const unsigned tg = og / nx;
            if (og + 1u == (tg + 1u) * nx) xb_add(&bar[XB_TOPGEN], 1u);
            else XB_SPIN(xb_ld(&bar[XB_TOPGEN]) == tg, bar);
            __builtin_amdgcn_fence(__ATOMIC_ACQUIRE, "agent");
            xb_add(&bar[XB_XGEN(b.x)], 1u);
            asm volatile("s_waitcnt vmcnt(0)" ::: "memory");
        } else {
            XB_SPIN(xb_ld(&bar[XB_XGEN(b.x)]) == gen, bar);
            __builtin_amdgcn_fence(__ATOMIC_ACQUIRE, "agent");
            asm volatile("s_waitcnt vmcnt(0)" ::: "memory");
        }
    }
    __syncthreads();
}

#ifndef REP_CVT
#define REP_CVT 1
#endif
#ifndef REP_NORM
#define REP_NORM 1
#endif
#ifndef REP_GIN
#define REP_GIN 1
#endif
#ifndef REP_PREP
#define REP_PREP 1
#endif
#ifndef REP_SSD
#define REP_SSD 1
#endif
#ifndef REP_GGRP
#define REP_GGRP 1
#endif
#ifndef REP_GBR
#define REP_GBR 1
#endif
#ifndef REP_GOUT
#define REP_GOUT 1
#endif
#ifndef REP_SYNC
#define REP_SYNC 1
#endif
#define GSYNC() do { for (int r_ = 0; r_ < REP_SYNC; ++r_) xcd_barrier(xb); } while (0)
__global__ void __launch_bounds__(512, 2) hybrid_fwd(Params P) {
    extern __shared__ __attribute__((aligned(16))) unsigned char shm_[];
    LAS unsigned char* lds = (LAS unsigned char*)shm_;
    cg::grid_group grid = cg::this_grid();
    const int G = (int)gridDim.x, c = (int)blockIdx.x;
    volatile LAS unsigned* xst = (volatile LAS unsigned*)(lds + LDS_BYTES - 16);
    if (threadIdx.x == 0) { xst[0] = 0u; xst[1] = 0u; xst[2] = 0u; xst[3] = 0u; }
    __syncthreads();
    const XcdBarrier xb = xcd_barrier_post(P.bar(), xst);
    for (int r = 0; r < REP_CVT; ++r) phase_convert(P, lds);
    phase_rmsnorm(P.x, P.norm_w, P.h(), nullptr, P.rowsq());
    grid.sync();
    GSYNC();
#pragma unroll 1
    for (int L = 0; L < 4; ++L) {
        const float* xin = L == 0 ? P.x : P.xcur();
        for (int r = 0; r < REP_GIN; ++r)
        { { const int t_ = opq(threadIdx.x); const float* bgp = P.b_gate + (size_t)L * 6144 + t_ * 12;
            const f32x4 b0 = *(const f32x4*)bgp, b1 = *(const f32x4*)(bgp + 4), b2 = *(const f32x4*)(bgp + 8);
            LAS u32x2* bl = (LAS u32x2*)(lds + 131072 + t_ * 24);
            u32x2 o0, o1, o2; o0.x = pk2(b0[0], b0[1]); o0.y = pk2(b0[2], b0[3]); o1.x = pk2(b1[0], b1[1]); o1.y = pk2(b1[2], b1[3]); o2.x = pk2(b2[0], b2[1]); o2.y = pk2(b2[2], b2[3]);
            bl[0] = o0; bl[1] = o1; bl[2] = o2;
            LAS _Float16* lr = (LAS _Float16*)(lds + 143360);
#pragma unroll
            for (int k = 0; k < 4; ++k) { const f32x4 q = *(const f32x4*)(P.rowsq() + t_ * 16 + k * 4);
#pragma unroll
                for (int j = 0; j < 4; ++j) lr[t_ * 16 + k * 4 + j] = (_Float16)rsqrtf(q[j] * (1.f / DM) + EPS); }
            __syncthreads(); }
          { Gemm g; g.A = P.h(); g.Bt = P.bt_in() + (size_t)L * NIN_PAD * DM; g.lda = DM; g.ldb = DM; g.K = DM; g.nM = 32; g.nN = 69; g.a_pn_off = 0;
            StaticOrder S; S.init(32, 69, G, c); EpiInProjU E; E.proj = P.proj(); E.dt = P.dt(); E.gates = P.gates(); E.lbias = lds + 131072; E.lrstd = (LAS const _Float16*)(lds + 143360);
            gemm_phase<EpiInProjU, true>(lds, g, S, E); } }
        GSYNC();
        for (int r = 0; r < REP_PREP; ++r) phase_prep(P, L);
        GSYNC();
        for (int r = 0; r < REP_SSD; ++r) for (int u = c; u < 256; u += G) ssd_states_unit(P, L, u, lds);
        GSYNC();
        const bool split = (G == 256);
        if (split) { if (c < 128) { for (int r = 0; r < REP_SSD; ++r) phase_scan(P, c, 128); } }
        else { for (int r = 0; r < REP_SSD; ++r) phase_scan(P, c, G); }
        for (int r = 0; r < REP_GGRP; ++r)
        { Gemm g; g.A = P.dpool(); g.Bt = P.bt_grp() + (size_t)L * 1024 * 256; g.lda = 1024; g.ldb = 256; g.K = 256; g.nM = 32; g.nN = 4; g.a_pn_off = 256;
          StaticOrder S; if (split) S.init(32, 4, 128, c >= 128 ? c - 128 : 1 << 20); else S.init(32, 4, G, c); EpiGrp E; E.act = P.act(); E.gates = P.gates(); E.scale = P.pool_scale + (size_t)L * 1024;
          gemm_phase(lds, g, S, E); }
        GSYNC();
        for (int r = 0; r < REP_SSD; ++r) for (int u = c; u < 256; u += G) ssd_out_unit(P, L, u, lds);
        GSYNC();
        for (int r = 0; r < REP_GBR; ++r)
        { Gemm g; g.A = P.act(); g.Bt = P.bt_br() + (size_t)L * DM * 4096; g.lda = 4096; g.ldb = 4096; g.K = 4096; g.nM = 32; g.nN = 8; g.a_pn_off = 0;
          StaticOrder S; S.init(32, 8, G, c); EpiBr E; E.merged = P.merged(); E.gates = P.gates();
          gemm_phase(lds, g, S, E); }
        GSYNC();
        for (int r = 0; r < REP_GOUT; ++r)
        { Gemm g; g.A = P.merged(); g.Bt = P.bt_out() + (size_t)L * DM * DM; g.lda = DM; g.ldb = DM; g.K = DM; g.nM = 32; g.nN = 8; g.a_pn_off = 0;
          StaticOrder S; S.init(32, 8, G, c); EpiOut E; E.xin = xin; E.xout = (r == REP_GOUT - 1) ? P.xcur() : P.states(); E.nw_next = (L < 3) ? P.norm_w + (size_t)(L + 1) * DM : nullptr; E.hout = P.h(); E.rowsq = P.rowsq();
          gemm_phase(lds, g, S, E); }
        GSYNC();
    }
    phase_rmsnorm(P.xcur(), P.final_norm_w, nullptr, P.out);
}

extern "C" void kernel_launch(void* const* d_in, const int* in_sizes, int n_in, void* d_out, int out_size, void* d_ws, size_t ws_size, hipStream_t stream) {
    static int grid_blocks = 0;
    if (!grid_blocks) {
        int dev = 0, cus = 0, per_cu = 0;
        hipGetDevice(&dev);
        hipDeviceGetAttribute(&cus, hipDeviceAttributeMultiprocessorCount, dev);
        if (hipFuncSetAttribute((const void*)hybrid_fwd, hipFuncAttributeMaxDynamicSharedMemorySize, LDS_BYTES) != hipSuccess) fprintf(stderr, "hipFuncSetAttribute failed\n");
        if (hipOccupancyMaxActiveBlocksPerMultiprocessor(&per_cu, (const void*)hybrid_fwd, 512, LDS_BYTES) != hipSuccess || per_cu < 1) { fprintf(stderr, "occupancy query gave %d\n", per_cu); per_cu = 1; }
        (void)hipGetLastError();
        grid_blocks = cus * per_cu;
        if (grid_blocks > 256) grid_blocks = 256;
    }
    Params p{};
    const float* const* in = (const float* const*)d_in;
    p.x = in[0]; p.norm_w = in[1]; p.w_in = in[2]; p.b_gate = in[3]; p.pool_w = in[4]; p.pool_scale = in[5]; p.ssm_conv_w = in[6]; p.ssm_conv_b = in[7];
    p.ssm_dt_bias = in[8]; p.ssm_a_log = in[9]; p.ssm_d = in[10]; p.ssm_norm_w = in[11]; p.sc_conv_w = in[12]; p.w_br_pool = in[13]; p.w_br_ssm = in[14];
    p.w_br_conv = in[15]; p.w_out = in[16]; p.final_norm_w = in[17];
    p.out = (float*)d_out;
    p.ws = (unsigned char*)d_ws;
    if (WS_END > ws_size) { fprintf(stderr, "workspace too small: need %zu have %zu\n", (size_t)WS_END, ws_size); return; }
    if (hipMemsetAsync((unsigned char*)d_ws + OFF_BAR, 0, 16384, stream) != hipSuccess) { fprintf(stderr, "memset of barrier words failed\n"); return; }
    void* args[] = {&p};
    hipError_t e = hipLaunchCooperativeKernel((const void*)hybrid_fwd, dim3(grid_blocks), dim3(512), args, LDS_BYTES, stream);
    if (e != hipSuccess) fprintf(stderr, "cooperative launch failed: %s (grid %d)\n", hipGetErrorString(e), grid_blocks);
}
```

```cpp
#include <hip/hip_runtime.h>
#include <hip/hip_cooperative_groups.h>
#include <cstdio>
#include <cstdint>
namespace cg = cooperative_groups;

#define LAS __attribute__((address_space(3)))
typedef unsigned short bf16_t;
typedef short bf16x8 __attribute__((ext_vector_type(8)));
typedef float f32x4 __attribute__((ext_vector_type(4)));
typedef unsigned u32x4 __attribute__((ext_vector_type(4)));
typedef unsigned u32x2 __attribute__((ext_vector_type(2)));

constexpr int M_TOK = 8192, DM = 2048, NPROJ = 17408, NIN_PAD = 17664, NIN_SRC = 17440;
constexpr int LDS_BYTES = 163840;
constexpr float EPS = 1e-6f;

constexpr size_t al256(size_t b) { return (b + 255) & ~(size_t)255; }
constexpr size_t OFF_BT_IN = 0;
constexpr size_t OFF_BT_GRP = OFF_BT_IN + al256((size_t)4 * NIN_PAD * DM * 2);
constexpr size_t OFF_BT_BR = OFF_BT_GRP + al256((size_t)4 * 1024 * 256 * 2);
constexpr size_t OFF_BT_OUT = OFF_BT_BR + al256((size_t)4 * DM * 4096 * 2);
constexpr size_t OFF_XCUR = OFF_BT_OUT + al256((size_t)4 * DM * DM * 2);
constexpr size_t OFF_H = OFF_XCUR + al256((size_t)M_TOK * DM * 4);
constexpr size_t OFF_PROJ = OFF_H + al256((size_t)M_TOK * DM * 2);
constexpr size_t OFF_DT = OFF_PROJ + al256((size_t)M_TOK * NPROJ * 2);
constexpr size_t OFF_DPOOL = OFF_DT + al256((size_t)M_TOK * 32 * 4);
constexpr size_t OFF_XBC = OFF_DPOOL + al256((size_t)M_TOK * 1024 * 2);
constexpr size_t OFF_ACT = OFF_XBC + al256((size_t)M_TOK * 3072 * 2);
constexpr size_t OFF_STATES = OFF_ACT + al256((size_t)M_TOK * 4096 * 2);
constexpr size_t OFF_PREV = OFF_STATES + al256((size_t)64 * 32 * 8192 * 4);
constexpr size_t OFF_DECAY = OFF_PREV + al256((size_t)64 * 32 * 8192 * 2);
constexpr size_t OFF_MERGED = OFF_DECAY + al256((size_t)64 * 32 * 4);
constexpr size_t OFF_GATES = OFF_MERGED + al256((size_t)M_TOK * DM * 2);
constexpr size_t OFF_BAR = OFF_GATES + al256((size_t)4 * M_TOK * DM * 2);
constexpr size_t OFF_ROWSQ = OFF_BAR + 16384;
constexpr size_t WS_END = OFF_ROWSQ + 32768;

struct Params {
    const float *x, *norm_w, *w_in, *b_gate, *pool_w, *pool_scale, *ssm_conv_w, *ssm_conv_b, *ssm_dt_bias, *ssm_a_log, *ssm_d,
        *ssm_norm_w, *sc_conv_w, *w_br_pool, *w_br_ssm, *w_br_conv, *w_out, *final_norm_w;
    float* out;
    unsigned char* ws;
    __device__ __forceinline__ bf16_t* bt_in() const { return (bf16_t*)(ws + OFF_BT_IN); }
    __device__ __forceinline__ bf16_t* bt_grp() const { return (bf16_t*)(ws + OFF_BT_GRP); }
    __device__ __forceinline__ bf16_t* bt_br() const { return (bf16_t*)(ws + OFF_BT_BR); }
    __device__ __forceinline__ bf16_t* bt_out() const { return (bf16_t*)(ws + OFF_BT_OUT); }
    __device__ __forceinline__ float* xcur() const { return (float*)(ws + OFF_XCUR); }
    __device__ __forceinline__ bf16_t* h() const { return (bf16_t*)(ws + OFF_H); }
    __device__ __forceinline__ bf16_t* proj() const { return (bf16_t*)(ws + OFF_PROJ); }
    __device__ __forceinline__ float* dt() const { return (float*)(ws + OFF_DT); }
    __device__ __forceinline__ bf16_t* dpool() const { return (bf16_t*)(ws + OFF_DPOOL); }
    __device__ __forceinline__ bf16_t* xbc() const { return (bf16_t*)(ws + OFF_XBC); }
    __device__ __forceinline__ bf16_t* act() const { return (bf16_t*)(ws + OFF_ACT); }
    __device__ __forceinline__ float* states() const { return (float*)(ws + OFF_STATES); }
    __device__ __forceinline__ bf16_t* prev() const { return (bf16_t*)(ws + OFF_PREV); }
    __device__ __forceinline__ float* decay() const { return (float*)(ws + OFF_DECAY); }
    __device__ __forceinline__ bf16_t* merged() const { return (bf16_t*)(ws + OFF_MERGED); }
    __device__ __forceinline__ bf16_t* gates() const { return (bf16_t*)(ws + OFF_GATES); }
    __device__ __forceinline__ unsigned* bar() const { return (unsigned*)(ws + OFF_BAR); }
    __device__ __forceinline__ float* rowsq() const { return (float*)(ws + OFF_ROWSQ); }
};

__device__ __forceinline__ unsigned pk2(float lo, float hi) { unsigned r; asm volatile("v_cvt_pk_bf16_f32 %0, %1, %2" : "=v"(r) : "v"(lo), "v"(hi)); return r; }
__device__ __forceinline__ float bflo(unsigned v) { return __uint_as_float(v << 16); }
__device__ __forceinline__ float bfhi(unsigned v) { return __uint_as_float(v & 0xffff0000u); }
__device__ __forceinline__ void unpack8(const u32x4 v, float (&f)[8]) {
    f[0] = bflo(v.x); f[1] = bfhi(v.x); f[2] = bflo(v.y); f[3] = bfhi(v.y); f[4] = bflo(v.z); f[5] = bfhi(v.z); f[6] = bflo(v.w); f[7] = bfhi(v.w);
}
__device__ __forceinline__ u32x4 pack8(const float (&f)[8]) { u32x4 o; o.x = pk2(f[0], f[1]); o.y = pk2(f[2], f[3]); o.z = pk2(f[4], f[5]); o.w = pk2(f[6], f[7]); return o; }
__device__ __forceinline__ float sigmoidf_(float v) { return __builtin_amdgcn_rcpf(1.f + __builtin_amdgcn_exp2f(-1.44269504f * v)); }
__device__ __forceinline__ float siluf_(float v) { return v * __builtin_amdgcn_rcpf(1.f + __builtin_amdgcn_exp2f(-1.44269504f * v)); }
__device__ __forceinline__ float softplusf_(float v) { return v > 20.f ? v : log1pf(expf(v)); }
__device__ __forceinline__ float wave_sum(float v) {
#pragma unroll
    for (int o = 1; o < 64; o <<= 1) v += __shfl_xor(v, o);
    return v;
}
__device__ __forceinline__ float wave_scan_incl(float v, int lane) {
#pragma unroll
    for (int o = 1; o < 64; o <<= 1) { const float t = __shfl_up(v, o); if (lane >= o) v += t; }
    return v;
}
__device__ __forceinline__ int opq(int v) { asm volatile("" : "+v"(v)); return v; }
__device__ __forceinline__ unsigned lds_addr(LAS const void* p) { return (unsigned)(uintptr_t)p; }
__device__ __forceinline__ bf16x8 mk_frag(u32x2 a, u32x2 b) { u32x4 r; r.x = a.x; r.y = a.y; r.z = b.x; r.w = b.y; return __builtin_bit_cast(bf16x8, r); }
template <int OFF2>
__device__ __forceinline__ bf16x8 tr_frag(unsigned addr) {
    u32x2 a, b;
    asm volatile("ds_read_b64_tr_b16 %0, %2\n\tds_read_b64_tr_b16 %1, %2 offset:%3\n\ts_waitcnt lgkmcnt(0)" : "=&v"(a), "=&v"(b) : "v"(addr), "n"(OFF2) : "memory");
    return mk_frag(a, b);
}
template <int OFF2, int STRIDE>
__device__ __forceinline__ void tr_frag2(unsigned addr, bf16x8& f0, bf16x8& f1) {
    u32x2 a0, b0, a1, b1;
    asm volatile("ds_read_b64_tr_b16 %0, %4\n\tds_read_b64_tr_b16 %1, %4 offset:%5\n\tds_read_b64_tr_b16 %2, %4 offset:%6\n\tds_read_b64_tr_b16 %3, %4 offset:%7\n\ts_waitcnt lgkmcnt(0)"
                 : "=&v"(a0), "=&v"(b0), "=&v"(a1), "=&v"(b1) : "v"(addr), "n"(OFF2), "n"(STRIDE), "n"(STRIDE + OFF2) : "memory");
    f0 = mk_frag(a0, b0); f1 = mk_frag(a1, b1);
}
template <int OFF2, int STRIDE>
__device__ __forceinline__ void tr_frag4(unsigned addr, bf16x8 (&f)[4]) {
    u32x2 a0, b0, a1, b1, a2, b2, a3, b3;
    asm volatile("ds_read_b64_tr_b16 %0, %8\n\tds_read_b64_tr_b16 %1, %8 offset:%9\n\tds_read_b64_tr_b16 %2, %8 offset:%10\n\tds_read_b64_tr_b16 %3, %8 offset:%11\n\t"
                 "ds_read_b64_tr_b16 %4, %8 offset:%12\n\tds_read_b64_tr_b16 %5, %8 offset:%13\n\tds_read_b64_tr_b16 %6, %8 offset:%14\n\tds_read_b64_tr_b16 %7, %8 offset:%15\n\ts_waitcnt lgkmcnt(0)"
                 : "=&v"(a0), "=&v"(b0), "=&v"(a1), "=&v"(b1), "=&v"(a2), "=&v"(b2), "=&v"(a3), "=&v"(b3)
                 : "v"(addr), "n"(OFF2), "n"(STRIDE), "n"(STRIDE + OFF2), "n"(2 * STRIDE), "n"(2 * STRIDE + OFF2), "n"(3 * STRIDE), "n"(3 * STRIDE + OFF2) : "memory");
    f[0] = mk_frag(a0, b0); f[1] = mk_frag(a1, b1); f[2] = mk_frag(a2, b2); f[3] = mk_frag(a3, b3);
}

template <int OFF2, int O1, int O2, int O3>
__device__ __forceinline__ void tr_frag4o(unsigned addr, bf16x8 (&f)[4]) {
    u32x2 a0, b0, a1, b1, a2, b2, a3, b3;
    asm volatile("ds_read_b64_tr_b16 %0, %8\n\tds_read_b64_tr_b16 %1, %8 offset:%9\n\tds_read_b64_tr_b16 %2, %8 offset:%10\n\tds_read_b64_tr_b16 %3, %8 offset:%11\n\t"
                 "ds_read_b64_tr_b16 %4, %8 offset:%12\n\tds_read_b64_tr_b16 %5, %8 offset:%13\n\tds_read_b64_tr_b16 %6, %8 offset:%14\n\tds_read_b64_tr_b16 %7, %8 offset:%15\n\ts_waitcnt lgkmcnt(0)"
                 : "=&v"(a0), "=&v"(b0), "=&v"(a1), "=&v"(b1), "=&v"(a2), "=&v"(b2), "=&v"(a3), "=&v"(b3)
                 : "v"(addr), "n"(OFF2), "n"(O1), "n"(O1 + OFF2), "n"(O2), "n"(O2 + OFF2), "n"(O3), "n"(O3 + OFF2) : "memory");
    f[0] = mk_frag(a0, b0); f[1] = mk_frag(a1, b1); f[2] = mk_frag(a2, b2); f[3] = mk_frag(a3, b3);
}

constexpr int BM = 256, BK = 64, HALF = 128, HTB = HALF * BK * 2, NXCD = 8, WGM = 8;
__device__ __forceinline__ int lds_byte(int r, int c) { const int st = (r >> 4) * 2 + (c >> 5), rr = r & 15, cc = c & 31, ob = rr * 64 + cc * 2; return st * 1024 + (ob ^ (((ob >> 9) & 1) << 5)); }
__device__ __forceinline__ void stage_rc(int b, int& R, int& C) { const int st = b / 1024, sb = b % 1024, swz = sb ^ (((sb >> 9) & 1) << 5); R = (st >> 1) * 16 + swz / 64; C = (st & 1) * 32 + (swz % 64) / 2; }
__device__ __forceinline__ int perm32(int rho) { const int n = rho >> 4, i = rho & 15; return 8 * (i >> 2) + 4 * n + (i & 3); }

struct Unit { int pm, pn; };
struct Gemm { const bf16_t* A; const bf16_t* Bt; int lda, ldb, K, nM, nN, a_pn_off; };
struct StaticOrder {
    int nM, nN, nwg, G, c;
    __device__ void init(int nM_, int nN_, int G_, int c_) { nM = nM_; nN = nN_; nwg = nM * nN; G = G_; c = c_; }
    __device__ bool next(int i, Unit& u) const {
        const long L = (long)i * G + c; if (L >= nwg) return false;
        int wgid = (int)L; { const int q = nwg / NXCD, r = nwg % NXCD, xcd = wgid % NXCD, off = wgid / NXCD; wgid = (xcd < r ? xcd * (q + 1) : r * (q + 1) + (xcd - r) * q) + off; }
        const int nig = WGM * nN, gid = wgid / nig, fm = gid * WGM, gsz = (nM - fm) < WGM ? (nM - fm) : WGM;
        u.pm = fm + ((wgid % nig) % gsz); u.pn = (wgid % nig) / gsz; return true;
    }
};

template <class Epi, bool ALIGN_EPI = false, bool SP2 = true>
__device__ __forceinline__ void gemm_phase(LAS unsigned char* lds, const Gemm g, const StaticOrder& S, const Epi& E) {
    const int tid = opq(threadIdx.x), wid = __builtin_amdgcn_readfirstlane(tid >> 6), lane = tid & 63, wr = wid >> 2, wc = wid & 3, fr = lane & 15, fq = lane >> 4;
    int K_ = g.K; asm volatile("" : "+s"(K_)); const int K = K_, nt = K / BK;
    unsigned voffA[2], voffB[2];
#pragma unroll
    for (int i = 0; i < 2; ++i) { int R, C; stage_rc(tid * 16 + i * 8192, R, C); const int Rb = (R & ~31) + perm32(R & 31);
        voffA[i] = (unsigned)(R * g.lda + C) * 2u; voffB[i] = (unsigned)(Rb * g.ldb + C) * 2u; }
    const size_t kstep = (size_t)(BK * 2);
    const size_t hstepA = (size_t)HALF * g.lda * 2, hstepB = (size_t)HALF * g.ldb * 2;
    const size_t tstepA = 2 * hstepA, tstepB = 2 * hstepB;
    const unsigned ldsw = (unsigned)wid * 1024u;
    const int aoff = lds_byte(wr * 64 + fr, fq * 8), boff = lds_byte(wc * 32 + fr, fq * 8);
#define PG8_SA(b, h) (((b) * 2 + (h)) * HTB)
#define PG8_SB(b, h) ((4 + (b) * 2 + (h)) * HTB)
#define PG8_STAGE(bufoff, gbase, voff) do { _Pragma("unroll") for (int _i = 0; _i < 2; ++_i) \
        __builtin_amdgcn_global_load_lds((const unsigned*)((const char*)(gbase) + (voff)[_i]), (LAS unsigned*)(lds + (bufoff) + ldsw + _i * 8192), 16, 0, 0); } while (0)
#define PG8_LDA(dst, b, h) do { _Pragma("unroll") for (int m = 0; m < 4; ++m) _Pragma("unroll") for (int k = 0; k < 2; ++k) dst[m][k] = *(const LAS bf16x8*)(lds + PG8_SA(b, h) + aoff + m * 2048 + k * 1024); } while (0)
#define PG8_LDB(dst, b, h) do { _Pragma("unroll") for (int n = 0; n < 2; ++n) _Pragma("unroll") for (int k = 0; k < 2; ++k) dst[n][k] = *(const LAS bf16x8*)(lds + PG8_SB(b, h) + boff + n * 2048 + k * 1024); } while (0)
#define PG8_MMA(ai, bj, At, Bt) do { __builtin_amdgcn_s_setprio(1); _Pragma("unroll") for (int m = 0; m < 4; ++m) _Pragma("unroll") for (int n = 0; n < 2; ++n) _Pragma("unroll") for (int k = 0; k < 2; ++k) \
        acc[ai][bj][m][n] = __builtin_amdgcn_mfma_f32_16x16x32_bf16(Bt[n][k], At[m][k], acc[ai][bj][m][n], 0, 0, 0); __builtin_amdgcn_s_setprio(0); } while (0)
#define PG8_WAIT_V(n) asm volatile("s_waitcnt vmcnt(" #n ")" ::: "memory")
#define PG8_WAIT_L(n) asm volatile("s_waitcnt lgkmcnt(" #n ")" ::: "memory")
#define PG8_BAR __builtin_amdgcn_s_barrier()
#define PG8_SCHED __builtin_amdgcn_sched_barrier(0)
    Unit cur, nxt; int ui = 0;
    if (!S.next(0, cur)) return;
    f32x4 acc[2][2][4][2];
#pragma unroll
    for (int a = 0; a < 2; ++a)
#pragma unroll
        for (int b = 0; b < 2; ++b)
#pragma unroll
            for (int m = 0; m < 4; ++m)
#pragma unroll
                for (int n = 0; n < 2; ++n) acc[a][b][m][n] = (f32x4){0.f, 0.f, 0.f, 0.f};
    bf16x8 At[4][2], B0[2][2], B1[2][2];
    const char* cA = (const char*)g.A + (size_t)cur.pm * tstepA + (size_t)cur.pn * g.a_pn_off * 2; const char* cB = (const char*)g.Bt + (size_t)cur.pn * tstepB;
    if constexpr (SP2) {
        PG8_STAGE(PG8_SB(0, 0), cB, voffB); PG8_STAGE(PG8_SB(0, 1), cB + hstepB, voffB); PG8_STAGE(PG8_SA(0, 0), cA, voffA); PG8_STAGE(PG8_SA(0, 1), cA + hstepA, voffA);
        if (wr == 1) PG8_BAR;
        PG8_WAIT_V(2); PG8_BAR;
        PG8_STAGE(PG8_SB(1, 0), cB + kstep, voffB); PG8_STAGE(PG8_SA(1, 0), cA + kstep, voffA); PG8_STAGE(PG8_SB(1, 1), cB + hstepB + kstep, voffB);
        PG8_WAIT_V(6); PG8_BAR;
    } else {
    PG8_STAGE(PG8_SB(0, 0), cB, voffB); PG8_STAGE(PG8_SA(0, 0), cA, voffA); PG8_STAGE(PG8_SB(0, 1), cB + hstepB, voffB); PG8_STAGE(PG8_SA(0, 1), cA + hstepA, voffA);
    if (wr == 1) PG8_BAR;
    PG8_WAIT_V(4); PG8_BAR;
    PG8_STAGE(PG8_SB(1, 0), cB + kstep, voffB); PG8_STAGE(PG8_SA(1, 0), cA + kstep, voffA); PG8_STAGE(PG8_SB(1, 1), cB + hstepB + kstep, voffB);
    PG8_WAIT_V(6); PG8_BAR;
    }
    for (;;) {
        const bool has_next = S.next(ui + 1, nxt);
        const char* nA = has_next ? (const char*)g.A + (size_t)nxt.pm * tstepA + (size_t)nxt.pn * g.a_pn_off * 2 : cA; const char* nB = has_next ? (const char*)g.Bt + (size_t)nxt.pn * tstepB : cB;
        for (int t = 0; t < nt; t += 2) {
            const bool last = (t == nt - 2);
            const char* a1 = cA + (size_t)(t + 1) * kstep;
            const char* a2 = last ? nA : cA + (size_t)(t + 2) * kstep; const char* b2 = last ? nB : cB + (size_t)(t + 2) * kstep;
            const char* a3 = a2 + kstep; const char* b3 = b2 + kstep;
            if constexpr (Epi::MID) { if (t == 16 || t == 48) { if (wr == 0) PG8_BAR; E.mid(acc, cur, t, wr, wc, fr, fq); if (wr == 1) PG8_BAR; } }
            if constexpr (SP2) {
            PG8_LDB(B0, 0, 0); PG8_LDB(B1, 0, 1); PG8_SCHED; PG8_LDA(At, 0, 0); PG8_STAGE(PG8_SA(1, 1), a1 + hstepA, voffA);
            PG8_WAIT_V(8); PG8_WAIT_L(0); PG8_BAR; PG8_MMA(0, 0, At, B0); PG8_MMA(0, 1, At, B1); PG8_BAR; PG8_SCHED;
            PG8_LDA(At, 0, 1); PG8_STAGE(PG8_SB(0, 0), b2, voffB); PG8_STAGE(PG8_SB(0, 1), b2 + hstepB, voffB); PG8_STAGE(PG8_SA(0, 0), a2, voffA);
            PG8_WAIT_V(8); PG8_WAIT_L(0); PG8_BAR; PG8_MMA(1, 0, At, B0); PG8_MMA(1, 1, At, B1); PG8_BAR; PG8_SCHED;
            PG8_LDB(B0, 1, 0); PG8_LDB(B1, 1, 1); PG8_SCHED; PG8_LDA(At, 1, 0); PG8_STAGE(PG8_SA(0, 1), a2 + hstepA, voffA);
            PG8_WAIT_V(8); PG8_WAIT_L(0); PG8_BAR; PG8_MMA(0, 0, At, B0); PG8_MMA(0, 1, At, B1); PG8_BAR; PG8_SCHED;
            PG8_LDA(At, 1, 1); PG8_STAGE(PG8_SB(1, 0), b3, voffB); PG8_STAGE(PG8_SB(1, 1), b3 + hstepB, voffB); PG8_STAGE(PG8_SA(1, 0), a3, voffA);
            PG8_WAIT_V(8); PG8_WAIT_L(0); PG8_BAR; PG8_MMA(1, 0, At, B0); PG8_MMA(1, 1, At, B1); PG8_BAR; PG8_SCHED;
            } else {
            PG8_LDB(B0, 0, 0); PG8_SCHED; PG8_LDA(At, 0, 0); PG8_STAGE(PG8_SA(1, 1), a1 + hstepA, voffA);
            PG8_WAIT_L(8); PG8_BAR; PG8_WAIT_L(0); PG8_MMA(0, 0, At, B0); PG8_BAR; PG8_SCHED;
            PG8_LDB(B1, 0, 1); PG8_STAGE(PG8_SB(0, 0), b2, voffB);
            PG8_BAR; PG8_WAIT_L(0); PG8_MMA(0, 1, At, B1); PG8_BAR;
            PG8_LDA(At, 0, 1); PG8_STAGE(PG8_SA(0, 0), a2, voffA);
            PG8_BAR; PG8_WAIT_L(0); PG8_MMA(1, 0, At, B0); PG8_BAR; PG8_SCHED;
            PG8_STAGE(PG8_SB(0, 1), b2 + hstepB, voffB);
            PG8_WAIT_V(6); PG8_BAR; PG8_MMA(1, 1, At, B1); PG8_BAR;
            PG8_LDB(B0, 1, 0); PG8_SCHED; PG8_LDA(At, 1, 0); PG8_STAGE(PG8_SA(0, 1), a2 + hstepA, voffA);
            PG8_WAIT_L(8); PG8_BAR; PG8_WAIT_L(0); PG8_MMA(0, 0, At, B0); PG8_BAR; PG8_SCHED;
            PG8_LDB(B1, 1, 1); PG8_STAGE(PG8_SB(1, 0), b3, voffB);
            PG8_BAR; PG8_WAIT_L(0); PG8_MMA(0, 1, At, B1); PG8_BAR;
            PG8_LDA(At, 1, 1); PG8_STAGE(PG8_SA(1, 0), a3, voffA);
            PG8_BAR; PG8_WAIT_L(0); PG8_MMA(1, 0, At, B0); PG8_BAR; PG8_SCHED;
            PG8_STAGE(PG8_SB(1, 1), b3 + hstepB, voffB);
            PG8_WAIT_V(6); PG8_BAR; PG8_MMA(1, 1, At, B1); PG8_BAR;
            }
        }
        if constexpr (ALIGN_EPI) { if (wr == 0) PG8_BAR; }
        E(acc, cur, wr, wc, fr, fq);
        if (!has_next) break;
#pragma unroll
        for (int a = 0; a < 2; ++a)
#pragma unroll
            for (int b = 0; b < 2; ++b)
#pragma unroll
                for (int m = 0; m < 4; ++m)
#pragma unroll
                    for (int n = 0; n < 2; ++n) acc[a][b][m][n] = (f32x4){0.f, 0.f, 0.f, 0.f};
        cur = nxt; cA = nA; cB = nB; ++ui;
        if constexpr (ALIGN_EPI) { if (wr == 1) PG8_BAR; }
    }
    PG8_WAIT_V(0);
    if constexpr (!ALIGN_EPI) { if (wr == 0) PG8_BAR; }
    PG8_BAR;
#undef PG8_SA
#undef PG8_SB
#undef PG8_STAGE
#undef PG8_LDA
#undef PG8_LDB
#undef PG8_MMA
#undef PG8_WAIT_V
#undef PG8_WAIT_L
#undef PG8_BAR
#undef PG8_SCHED
}

typedef f32x4 AccT[2][2][4][2];

struct EpiInProj {
    static constexpr bool MID = false;
    bf16_t* proj; float* dt; const float* b_gate; bf16_t* gates; int pn_off; LAS const unsigned char* lbias;
    __device__ __forceinline__ void operator()(const AccT& acc, const Unit& u, int wr, int wc, int fr, int fq) const {
        fr = opq(fr); fq = opq(fq);
        const int row0 = u.pm * BM + wr * 64 + fr;
        const int upn = u.pn + pn_off;
        if (upn != 44) {
            const int col0 = upn * BM + wc * 32 + 8 * fq; const bool gate = upn >= 45, pgt = (upn >= 4) && (upn < 8), tl = gate || pgt;
            const int gk = gate ? (upn - 45) >> 3 : 3, gp = gate ? (upn - 45) & 7 : (upn & 3);
            const int tid = (wr * 4 + wc) * 64 + fq * 16 + fr;
            bf16_t* gbase = gates + ((size_t)((gk * 32 + u.pm) * 8 + gp) * 16 * 512 + tid) * 8;
            f32x4 bg[2][2];
#pragma unroll
            for (int bj = 0; bj < 2; ++bj)
#pragma unroll
                for (int n = 0; n < 2; ++n) { const u32x2 t = *(const LAS u32x2*)(lbias + ((gate ? (col0 + bj * HALF - 11520) : 0) + 4 * n) * 2); bg[bj][n] = (f32x4){bflo(t.x), bfhi(t.x), bflo(t.y), bfhi(t.y)}; }
#pragma unroll
            for (int ai = 0; ai < 2; ++ai)
#pragma unroll
                for (int m = 0; m < 4; ++m) { bf16_t* rowp = proj + (size_t)(row0 + ai * HALF + m * 16) * NPROJ + col0;
#pragma unroll
                    for (int bj = 0; bj < 2; ++bj) { f32x4 v0 = acc[ai][bj][m][0], v1 = acc[ai][bj][m][1];
#pragma unroll
                        for (int j = 0; j < 4; ++j) { const float s0 = sigmoidf_(v0[j] + bg[bj][0][j]), s1 = sigmoidf_(v1[j] + bg[bj][1][j]); v0[j] = gate ? s0 : v0[j]; v1[j] = gate ? s1 : v1[j]; }
                        u32x4 o; o.x = pk2(v0[0], v0[1]); o.y = pk2(v0[2], v0[3]); o.z = pk2(v1[0], v1[1]); o.w = pk2(v1[2], v1[3]);
                        bf16_t* dst = tl ? gbase + (size_t)(((ai * 4 + m) * 2 + bj) * 512) * 8 : rowp + bj * HALF;
                        *(u32x4*)dst = o; } }
        } else if (wc == 0) {
#pragma unroll
            for (int ai = 0; ai < 2; ++ai)
#pragma unroll
                for (int m = 0; m < 4; ++m) { float* rp = dt + (size_t)(row0 + ai * HALF + m * 16) * 32 + 8 * fq;
                    *(f32x4*)rp = acc[ai][0][m][0]; *(f32x4*)(rp + 4) = acc[ai][0][m][1]; }
        }
    }
};
struct EpiInProjU {
    static constexpr bool MID = false;
    bf16_t* proj; float* dt; bf16_t* gates; LAS const unsigned char* lbias; LAS const _Float16* lrstd;
    __device__ __forceinline__ void operator()(const AccT& acc, const Unit& u, int wr, int wc, int fr, int fq) const {
        fr = opq(fr); fq = opq(fq);
        const int row0 = u.pm * BM + wr * 64 + fr;
        const int tid = (wr * 4 + wc) * 64 + fq * 16 + fr;
        float rs[2][4];
#pragma unroll
        for (int ai = 0; ai < 2; ++ai)
#pragma unroll
            for (int m = 0; m < 4; ++m) rs[ai][m] = (float)lrstd[row0 + ai * HALF + m * 16];
        if (u.pn >= 45) {
            const int gpn = u.pn - 45, colb = gpn * BM + wc * 32 + 8 * fq;
            bf16_t* gbase = gates + ((size_t)(((gpn >> 3) * 32 + u.pm) * 8 + (gpn & 7)) * 16 * 512 + tid) * 8;
            f32x4 bg[2][2];
#pragma unroll
            for (int bj = 0; bj < 2; ++bj)
#pragma unroll
                for (int n = 0; n < 2; ++n) { const u32x2 t = *(const LAS u32x2*)(lbias + (colb + bj * HALF + 4 * n) * 2); bg[bj][n] = (f32x4){bflo(t.x), bfhi(t.x), bflo(t.y), bfhi(t.y)}; }
#pragma unroll
            for (int ai = 0; ai < 2; ++ai)
#pragma unroll
                for (int m = 0; m < 4; ++m)
#pragma unroll
                    for (int bj = 0; bj < 2; ++bj) { f32x4 v0 = acc[ai][bj][m][0], v1 = acc[ai][bj][m][1];
#pragma unroll
                        for (int j = 0; j < 4; ++j) { v0[j] = sigmoidf_(v0[j] * rs[ai][m] + bg[bj][0][j]); v1[j] = sigmoidf_(v1[j] * rs[ai][m] + bg[bj][1][j]); }
                        u32x4 o; o.x = pk2(v0[0], v0[1]); o.y = pk2(v0[2], v0[3]); o.z = pk2(v1[0], v1[1]); o.w = pk2(v1[2], v1[3]);
                        *(u32x4*)(gbase + (size_t)(((ai * 4 + m) * 2 + bj) * 512) * 8) = o; }
        } else if (u.pn < 44) {
            const int col0 = u.pn * BM + wc * 32 + 8 * fq; const bool tl = (u.pn >= 4) && (u.pn < 8);
            bf16_t* gbase = gates + ((size_t)((3 * 32 + u.pm) * 8 + (u.pn & 3)) * 16 * 512 + tid) * 8;
#pragma unroll
            for (int ai = 0; ai < 2; ++ai)
#pragma unroll
                for (int m = 0; m < 4; ++m) { bf16_t* rowp = proj + (size_t)(row0 + ai * HALF + m * 16) * NPROJ + col0;
#pragma unroll
                    for (int bj = 0; bj < 2; ++bj) { const f32x4 v0 = acc[ai][bj][m][0] * rs[ai][m], v1 = acc[ai][bj][m][1] * rs[ai][m];
                        u32x4 o; o.x = pk2(v0[0], v0[1]); o.y = pk2(v0[2], v0[3]); o.z = pk2(v1[0], v1[1]); o.w = pk2(v1[2], v1[3]);
                        bf16_t* dst = tl ? gbase + (size_t)(((ai * 4 + m) * 2 + bj) * 512) * 8 : rowp + bj * HALF;
                        *(u32x4*)dst = o; } }
        } else if (wc == 0) {
#pragma unroll
            for (int ai = 0; ai < 2; ++ai)
#pragma unroll
                for (int m = 0; m < 4; ++m) { float* rp = dt + (size_t)(row0 + ai * HALF + m * 16) * 32 + 8 * fq;
                    *(f32x4*)rp = acc[ai][0][m][0] * rs[ai][m]; *(f32x4*)(rp + 4) = acc[ai][0][m][1] * rs[ai][m]; }
        }
    }
};
struct EpiGrp {
    static constexpr bool MID = false;
    bf16_t* act; const bf16_t* gates; const float* scale;
    __device__ __forceinline__ void operator()(const AccT& acc, const Unit& u, int wr, int wc, int fr, int fq) const {
        fr = opq(fr); fq = opq(fq);
        const int row0 = u.pm * BM + wr * 64 + fr, col0 = u.pn * BM + wc * 32 + 8 * fq;
        const int tid = (wr * 4 + wc) * 64 + fq * 16 + fr;
        const bf16_t* pg = gates + ((size_t)((3 * 32 + u.pm) * 8 + u.pn) * 16 * 512 + tid) * 8;
        f32x4 sc[2][2];
#pragma unroll
        for (int bj = 0; bj < 2; ++bj)
#pragma unroll
            for (int n = 0; n < 2; ++n) sc[bj][n] = *(const f32x4*)(scale + col0 + bj * HALF + 4 * n);
#pragma unroll
        for (int ai = 0; ai < 2; ++ai)
#pragma unroll
            for (int m = 0; m < 4; ++m) { const size_t row = (size_t)(row0 + ai * HALF + m * 16); if ((m & 1) == 0) asm volatile("" ::: "memory");
#pragma unroll
                for (int bj = 0; bj < 2; ++bj) { const int col = col0 + bj * HALF;
                    float gf[8]; unpack8(*(const u32x4*)(pg + ((ai * 4 + m) * 2 + bj) * 512 * 8), gf);
                    float o[8];
#pragma unroll
                    for (int j = 0; j < 4; ++j) { o[j] = acc[ai][bj][m][0][j] * sc[bj][0][j] * siluf_(gf[j]); o[4 + j] = acc[ai][bj][m][1][j] * sc[bj][1][j] * siluf_(gf[4 + j]); }
                    *(u32x4*)(act + row * 4096 + col) = pack8(o); } }
    }
};
struct EpiBr {
    static constexpr bool MID = true;
    bf16_t* merged; const bf16_t* gates;
    __device__ __forceinline__ const bf16_t* gptr(const Unit& u, int k, int wr, int wc, int fr, int fq) const {
        const int tid = (wr * 4 + wc) * 64 + fq * 16 + fr;
        return gates + ((size_t)((k * 32 + u.pm) * 8 + u.pn) * 16 * 512 + tid) * 8;
    }
    __device__ __forceinline__ void mid(AccT& acc, const Unit& u, int t, int wr, int wc, int fr, int fq) const {
        fr = opq(fr); fq = opq(fq);
        const int ka = (t == 16) ? 0 : 1;
        const bf16_t* pa = gptr(u, ka, wr, wc, fr, fq); const bf16_t* pb = gptr(u, ka + 1, wr, wc, fr, fq);
#pragma unroll
        for (int ai = 0; ai < 2; ++ai)
#pragma unroll
            for (int m = 0; m < 4; ++m) { if (m == 0) asm volatile("" ::: "memory");
#pragma unroll
                for (int bj = 0; bj < 2; ++bj) { const int o = ((ai * 4 + m) * 2 + bj) * 512 * 8; float ga[8], gb[8]; unpack8(*(const u32x4*)(pa + o), ga); unpack8(*(const u32x4*)(pb + o), gb);
#pragma unroll
                    for (int j = 0; j < 4; ++j) { acc[ai][bj][m][0][j] *= ga[j] * __builtin_amdgcn_rcpf(fmaxf(gb[j], 1e-20f)); acc[ai][bj][m][1][j] *= ga[4 + j] * __builtin_amdgcn_rcpf(fmaxf(gb[4 + j], 1e-20f)); } } }
    }
    __device__ __forceinline__ void operator()(const AccT& acc, const Unit& u, int wr, int wc, int fr, int fq) const {
        fr = opq(fr); fq = opq(fq);
        const int row0 = u.pm * BM + wr * 64 + fr, col0 = u.pn * BM + wc * 32 + 8 * fq;
        const bf16_t* pg = gptr(u, 2, wr, wc, fr, fq);
#pragma unroll
        for (int ai = 0; ai < 2; ++ai)
#pragma unroll
            for (int m = 0; m < 4; ++m) { const size_t row = (size_t)(row0 + ai * HALF + m * 16); if (m == 0) asm volatile("" ::: "memory");
#pragma unroll
                for (int bj = 0; bj < 2; ++bj) { const int col = col0 + bj * HALF; float g2[8]; unpack8(*(const u32x4*)(pg + ((ai * 4 + m) * 2 + bj) * 512 * 8), g2);
                    float o[8];
#pragma unroll
                    for (int j = 0; j < 4; ++j) { o[j] = acc[ai][bj][m][0][j] * g2[j]; o[4 + j] = acc[ai][bj][m][1][j] * g2[4 + j]; }
                    *(u32x4*)(merged + row * DM + col) = pack8(o); } }
    }
};
struct EpiOut {
    static constexpr bool MID = false;
    const float* xin; float* xout; const float* nw_next; bf16_t* hout; float* rowsq;
    __device__ __forceinline__ void operator()(const AccT& acc, const Unit& u, int wr, int wc, int fr, int fq) const {
        fr = opq(fr); fq = opq(fq);
        const int row0 = u.pm * BM + wr * 64 + fr, col0 = u.pn * BM + wc * 32 + 8 * fq;
        const bool fuse = nw_next != nullptr;
        f32x4 nw[2][2];
#pragma unroll
        for (int bj = 0; bj < 2; ++bj)
#pragma unroll
            for (int n = 0; n < 2; ++n) nw[bj][n] = fuse ? *(const f32x4*)(nw_next + col0 + bj * HALF + 4 * n) : (f32x4){0.f, 0.f, 0.f, 0.f};
#pragma unroll
        for (int ai = 0; ai < 2; ++ai)
#pragma unroll
            for (int m = 0; m < 4; ++m) { const int row = row0 + ai * HALF + m * 16; const size_t off = (size_t)row * DM + col0; float ssq = 0.f;
                if ((m & 1) == 0) asm volatile("" ::: "memory");
#pragma unroll
                for (int bj = 0; bj < 2; ++bj) {
                    const f32x4 x0 = *(const f32x4*)(xin + off + bj * HALF), x1 = *(const f32x4*)(xin + off + bj * HALF + 4);
                    const f32x4 y0 = x0 + acc[ai][bj][m][0], y1 = x1 + acc[ai][bj][m][1];
                    *(f32x4*)(xout + off + bj * HALF) = y0; *(f32x4*)(xout + off + bj * HALF + 4) = y1;
                    if (fuse) {
                        ssq += (y0[0] * y0[0] + y0[1] * y0[1]) + (y0[2] * y0[2] + y0[3] * y0[3]) + (y1[0] * y1[0] + y1[1] * y1[1]) + (y1[2] * y1[2] + y1[3] * y1[3]);
                        const f32x4 h0 = y0 * nw[bj][0], h1 = y1 * nw[bj][1];
                        u32x4 o; o.x = pk2(h0[0], h0[1]); o.y = pk2(h0[2], h0[3]); o.z = pk2(h1[0], h1[1]); o.w = pk2(h1[2], h1[3]);
                        *(u32x4*)(hout + off + bj * HALF) = o; } }
                if (fuse) { ssq += __shfl_xor(ssq, 16); ssq += __shfl_xor(ssq, 32); if (fq == 0) atomicAdd(rowsq + row, ssq); } }
    }
};

__device__ __forceinline__ void cvt_matrix(const float* src, int K, int N, bf16_t* dst, int ld_dst, int dst_koff, int mode, LAS float* scr, int lane, int gw, int ngw) {
    const int nblk = N / 32, nitems = (K / 64) * nblk;
    for (int item = gw; item < nitems; item += ngw) {
        const int kb = item / nblk, nb = item - kb * nblk, k0 = 64 * kb, n0 = 32 * nb;
        const float* sp = src + (size_t)(k0 + (lane >> 5)) * N + n0 + (lane & 31);
        float v[32];
#pragma unroll
        for (int i = 0; i < 32; ++i) v[i] = __builtin_nontemporal_load(sp + (size_t)(2 * i) * N);
#pragma unroll
        for (int i = 0; i < 32; ++i) scr[(2 * i + (lane >> 5)) * 33 + (lane & 31)] = v[i];
        asm volatile("s_waitcnt lgkmcnt(0)" ::: "memory");
        int drow0 = n0;
        if (mode == 1) drow0 = n0 < 7168 ? n0 : (n0 < 7200 ? 11264 : (n0 < 11296 ? n0 - 32 : n0 + 224));
        const int c = lane & 7;
#pragma unroll
        for (int j = 0; j < 4; ++j) { const int n = (lane >> 3) + 8 * j; float f[8];
#pragma unroll
            for (int i = 0; i < 8; ++i) f[i] = scr[(8 * c + i) * 33 + n];
            *(u32x4*)(dst + (size_t)(drow0 + n) * ld_dst + dst_koff + k0 + 8 * c) = pack8(f); }
        asm volatile("s_waitcnt lgkmcnt(0)" ::: "memory");
    }
}
__device__ __forceinline__ void phase_convert(const Params& P, LAS unsigned char* lds) {
    const int tid_ = opq(threadIdx.x), lane = tid_ & 63, wave = tid_ >> 6;
    LAS float* scr = (LAS float*)(lds + wave * 8448);
    const int gw = blockIdx.x * 8 + wave, ngw = gridDim.x * 8;
#pragma unroll 1
    for (int L = 0; L < 4; ++L) {
        cvt_matrix(P.w_in + (size_t)L * DM * NIN_SRC, DM, NIN_SRC, P.bt_in() + (size_t)L * NIN_PAD * DM, DM, 0, 1, scr, lane, gw, ngw);
#pragma unroll 1
        for (int g = 0; g < 4; ++g) cvt_matrix(P.pool_w + ((size_t)L * 4 + g) * 65536, 256, 256, P.bt_grp() + ((size_t)L * 4 + g) * 65536, 256, 0, 0, scr, lane, gw, ngw);
        cvt_matrix(P.w_br_pool + (size_t)L * 1024 * DM, 1024, DM, P.bt_br() + (size_t)L * DM * 4096, 4096, 0, 0, scr, lane, gw, ngw);
        cvt_matrix(P.w_br_ssm + (size_t)L * 2048 * DM, 2048, DM, P.bt_br() + (size_t)L * DM * 4096, 4096, 1024, 0, scr, lane, gw, ngw);
        cvt_matrix(P.w_br_conv + (size_t)L * 1024 * DM, 1024, DM, P.bt_br() + (size_t)L * DM * 4096, 4096, 3072, 0, scr, lane, gw, ngw);
        cvt_matrix(P.w_out + (size_t)L * DM * DM, DM, DM, P.bt_out() + (size_t)L * DM * DM, DM, 0, 0, scr, lane, gw, ngw);
        u32x4* z = (u32x4*)(P.bt_in() + (size_t)L * NIN_PAD * DM + (size_t)11296 * DM);
        for (int i = blockIdx.x * 512 + tid_; i < 224 * 256; i += gridDim.x * 512) z[i] = (u32x4){0u, 0u, 0u, 0u};
    }
}

__device__ __forceinline__ void phase_rmsnorm(const float* xin, const float* w, bf16_t* hout, float* fout, float* rowsq_out = nullptr) {
    const int tid_ = opq(threadIdx.x); const int lane = tid_ & 63, wave = tid_ >> 6;
    for (int row = blockIdx.x * 8 + wave; row < M_TOK; row += gridDim.x * 8) {
        const f32x4* xr = (const f32x4*)(xin + (size_t)row * DM) + lane;
        f32x4 v[8]; float s = 0.f;
#pragma unroll
        for (int j = 0; j < 8; ++j) { v[j] = xr[64 * j]; s += (v[j][0] * v[j][0] + v[j][1] * v[j][1]) + (v[j][2] * v[j][2] + v[j][3] * v[j][3]); }
        s = wave_sum(s);
        const float rstd = rowsq_out ? 1.f : rsqrtf(s * (1.f / DM) + EPS);
        if (rowsq_out && lane == 0) rowsq_out[row] = s;
#pragma unroll
        for (int j = 0; j < 8; ++j) { const f32x4 wv = ((const f32x4*)w)[lane + 64 * j]; const f32x4 o = v[j] * rstd * wv;
            if (hout) { u32x2 pk; pk.x = pk2(o[0], o[1]); pk.y = pk2(o[2], o[3]); *(u32x2*)(hout + (size_t)row * DM + (lane + 64 * j) * 4) = pk; }
            else *(f32x4*)(fout + (size_t)row * DM + (lane + 64 * j) * 4) = o; }
    }
}

__device__ __forceinline__ void phase_prep(const Params& P, int L) {
    const int gtid = blockIdx.x * 512 + opq(threadIdx.x), gsz = gridDim.x * 512;
    const u32x4 zero4 = (u32x4){0u, 0u, 0u, 0u};
    for (int i = gtid; i < M_TOK; i += gsz) P.rowsq()[i] = 0.f;
    for (int it = gtid; it < 512 * 128; it += gsz) {
        const int ch8 = it & 127, blk = it >> 7, g = ch8 >> 5, win = 2 << g, t0 = blk * 16, pos0 = t0 & 4095;
        const bf16_t* up = P.proj() + (size_t)t0 * NPROJ + ch8 * 8;
        float s[8];
#pragma unroll
        for (int i = 0; i < 8; ++i) s[i] = 0.f;
        const int nh = (win - 1) < pos0 ? (win - 1) : pos0;
        for (int i = 1; i <= nh; ++i) { float f[8]; unpack8(*(const u32x4*)(up - (ptrdiff_t)i * NPROJ), f);
#pragma unroll
            for (int k = 0; k < 8; ++k) s[k] += f[k]; }
#pragma unroll 1
        for (int jb = 0; jb < 16; jb += 4) {
            u32x4 cu[4], ol[4];
#pragma unroll
            for (int r = 0; r < 4; ++r) cu[r] = *(const u32x4*)(up + (ptrdiff_t)(jb + r) * NPROJ);
#pragma unroll
            for (int r = 0; r < 4; ++r) { const int jo = jb + r - win + 1; ol[r] = zero4; if (pos0 + jo >= 0) ol[r] = *(const u32x4*)(up + (ptrdiff_t)jo * NPROJ); }
#pragma unroll
            for (int r = 0; r < 4; ++r) {
                float cur[8], o[8], d[8]; unpack8(cu[r], cur); unpack8(ol[r], o);
                const int pos = pos0 + jb + r; const int cnt = (pos + 1) < win ? (pos + 1) : win; const float inv = 1.f / (float)cnt;
#pragma unroll
                for (int k = 0; k < 8; ++k) { s[k] += cur[k]; d[k] = s[k] * inv - cur[k]; s[k] -= o[k]; }
                *(u32x4*)(P.dpool() + (size_t)(t0 + jb + r) * 1024 + ch8 * 8) = pack8(d);
            }
        }
    }
    for (int it = gtid; it < 512 * 384; it += gsz) {
        const int ch8 = it % 384, blk = it / 384, ch = ch8 * 8, t0 = blk * 16, pos0 = t0 & 4095;
        const float* cw = P.ssm_conv_w + (size_t)L * 4 * 3072 + ch; const float* cb = P.ssm_conv_b + (size_t)L * 3072 + ch;
        float w0[8], w1[8], w2[8], w3[8], bb[8];
#pragma unroll
        for (int k = 0; k < 8; ++k) { w0[k] = cw[k]; w1[k] = cw[3072 + k]; w2[k] = cw[2 * 3072 + k]; w3[k] = cw[3 * 3072 + k]; bb[k] = cb[k]; }
        const bf16_t* src = P.proj() + (size_t)t0 * NPROJ + 4096 + ch;
        float x1[8], x2[8], x3[8];
#pragma unroll
        for (int k = 0; k < 8; ++k) { x1[k] = 0.f; x2[k] = 0.f; x3[k] = 0.f; }
        if (pos0 >= 3) { unpack8(*(const u32x4*)(src - (ptrdiff_t)1 * NPROJ), x1); unpack8(*(const u32x4*)(src - (ptrdiff_t)2 * NPROJ), x2); unpack8(*(const u32x4*)(src - (ptrdiff_t)3 * NPROJ), x3); }
#pragma unroll 1
        for (int jb = 0; jb < 16; jb += 8) {
            u32x4 cu[8];
#pragma unroll
            for (int r = 0; r < 8; ++r) cu[r] = *(const u32x4*)(src + (ptrdiff_t)(jb + r) * NPROJ);
#pragma unroll
            for (int r = 0; r < 8; ++r) {
                float cur[8], o[8]; unpack8(cu[r], cur);
#pragma unroll
                for (int k = 0; k < 8; ++k) { const float a = bb[k] + w0[k] * x3[k] + w1[k] * x2[k] + w2[k] * x1[k] + w3[k] * cur[k]; o[k] = siluf_(a); x3[k] = x2[k]; x2[k] = x1[k]; x1[k] = cur[k]; }
                *(u32x4*)(P.xbc() + (size_t)(t0 + jb + r) * 3072 + ch) = pack8(o);
            }
        }
    }
    for (int it = gtid; it < 512 * 128; it += gsz) {
        const int ch8 = it & 127, blk = it >> 7, ch = ch8 * 8, t0 = blk * 16, pos0 = t0 & 4095;
        const float* cw = P.sc_conv_w + (size_t)L * 3 * 1024 + ch;
        float w0[8], w1[8], w2[8];
#pragma unroll
        for (int k = 0; k < 8; ++k) { w0[k] = cw[k]; w1[k] = cw[1024 + k]; w2[k] = cw[2048 + k]; }
        const bf16_t* base = P.proj() + (size_t)t0 * NPROJ + 7168 + ch;
        float m1[8], m2[8];
#pragma unroll
        for (int k = 0; k < 8; ++k) { m1[k] = 0.f; m2[k] = 0.f; }
        if (pos0 >= 2) { float a[8], b[8], c[8], d[8];
            unpack8(*(const u32x4*)(base - (ptrdiff_t)1 * NPROJ + 1024), a); unpack8(*(const u32x4*)(base - (ptrdiff_t)1 * NPROJ + 2048), b);
            unpack8(*(const u32x4*)(base - (ptrdiff_t)2 * NPROJ + 1024), c); unpack8(*(const u32x4*)(base - (ptrdiff_t)2 * NPROJ + 2048), d);
#pragma unroll
            for (int k = 0; k < 8; ++k) { m1[k] = a[k] * b[k]; m2[k] = c[k] * d[k]; } }
#pragma unroll 1
        for (int jb = 0; jb < 16; jb += 4) {
            u32x4 rb[4], rc[4], rv[4], rg[4];
#pragma unroll
            for (int r = 0; r < 4; ++r) { const bf16_t* rp = base + (ptrdiff_t)(jb + r) * NPROJ;
                rb[r] = *(const u32x4*)(rp); rc[r] = *(const u32x4*)(rp + 1024); rv[r] = *(const u32x4*)(rp + 2048); rg[r] = *(const u32x4*)(rp + 3072); }
#pragma unroll
            for (int r = 0; r < 4; ++r) {
                float vb[8], vc[8], vv[8], vg[8], o[8];
                unpack8(rb[r], vb); unpack8(rc[r], vc); unpack8(rv[r], vv); unpack8(rg[r], vg);
#pragma unroll
                for (int k = 0; k < 8; ++k) { const float mc = vc[k] * vv[k]; const float cv = w0[k] * m2[k] + w1[k] * m1[k] + w2[k] * mc; o[k] = vb[k] * cv * siluf_(vg[k]); m2[k] = m1[k]; m1[k] = mc; }
                *(u32x4*)(P.act() + (size_t)(t0 + jb + r) * 4096 + 3072 + ch) = pack8(o);
            }
        }
    }
}

__device__ __forceinline__ void ssd_dt_scan(const Params& P, int L, int m0, int g, int bc, LAS float* acum, LAS float* aux, int mode) {
    const int tid_ = opq(threadIdx.x); const int lane = tid_ & 63, e = tid_ >> 6, h = g * 8 + e;
    const float bias = P.ssm_dt_bias[L * 32 + h], a = -expf(P.ssm_a_log[L * 32 + h]);
    const float d0 = softplusf_(P.dt()[(size_t)(m0 + lane) * 32 + h] + bias), d1 = softplusf_(P.dt()[(size_t)(m0 + 64 + lane) * 32 + h] + bias);
    const float c0 = wave_scan_incl(d0 * a, lane); const float tot0 = __shfl(c0, 63);
    const float c1 = wave_scan_incl(d1 * a, lane) + tot0; const float alast = __shfl(c1, 63);
    acum[e * 128 + lane] = c0; acum[e * 128 + 64 + lane] = c1;
    if (mode == 0) { aux[e * 128 + lane] = d0 * __expf(alast - c0); aux[e * 128 + 64 + lane] = d1 * __expf(alast - c1);
        if (lane == 0) P.decay()[bc * 32 + h] = __expf(alast); }
    else { aux[e * 128 + lane] = d0; aux[e * 128 + 64 + lane] = d1; }
}

__device__ __forceinline__ void ssd_states_unit(const Params& P, int L, int unit, LAS unsigned char* lds) {
    const int tid = opq(threadIdx.x), lane = tid & 63, w = tid >> 6, fr = lane & 15, fq = lane >> 4, q = fr >> 2, pp = lane & 3;
    const int g = unit & 3, bc = unit >> 2, m0 = bc * 128;
    LAS unsigned char* Bm = lds;
    LAS unsigned char* XW = lds + 36864;
    LAS float* acum = (LAS float*)(lds + 102400); LAS float* wl = (LAS float*)(lds + 106496);
    ssd_dt_scan(P, L, m0, g, bc, acum, wl, 0);
#pragma unroll
    for (int it = 0; it < 4; ++it) { const int idx = it * 512 + tid, row = idx >> 4, c = idx & 15;
        *(LAS u32x4*)(Bm + row * 288 + c * 16) = *(const u32x4*)(P.xbc() + (size_t)(m0 + row) * 3072 + 2048 + g * 128 + c * 8); }
    __syncthreads();
#pragma unroll 1
    for (int pass = 0; pass < 2; ++pass) {
#pragma unroll
        for (int it = 0; it < 8; ++it) { const int idx = it * 512 + tid, row = idx >> 5, c = idx & 31, hh = c >> 3, p8 = (c & 7) * 8;
            float f[8]; unpack8(*(const u32x4*)(P.xbc() + (size_t)(m0 + row) * 3072 + g * 512 + (pass * 4 + hh) * 64 + p8), f);
            const float wv = wl[(pass * 4 + hh) * 128 + row];
#pragma unroll
            for (int k = 0; k < 8; ++k) f[k] *= wv;
            *(LAS u32x4*)(XW + hh * 16384 + row * 128 + p8 * 2) = pack8(f); }
        __syncthreads();
        const int hh = w & 3, ph = w >> 2;
        f32x4 acc[2][8];
#pragma unroll
        for (int a = 0; a < 2; ++a)
#pragma unroll
            for (int b = 0; b < 8; ++b) acc[a][b] = (f32x4){0.f, 0.f, 0.f, 0.f};
        const unsigned xbase = lds_addr(XW) + hh * 16384 + (8 * fq + q) * 128 + (ph * 32 + 4 * pp) * 2;
        const unsigned bbase = lds_addr(Bm) + (8 * fq + q) * 288 + (4 * pp) * 2;
#pragma unroll
        for (int ks = 0; ks < 4; ++ks) {
            bf16x8 xf0, xf1; tr_frag2<512, 32>(xbase + ks * 4096, xf0, xf1);
#pragma unroll
            for (int nh = 0; nh < 2; ++nh) { bf16x8 bf[4]; tr_frag4<1152, 32>(bbase + ks * 9216 + nh * 128, bf);
#pragma unroll
                for (int nn = 0; nn < 4; ++nn) { const int nt = nh * 4 + nn;
                    acc[0][nt] = __builtin_amdgcn_mfma_f32_16x16x32_bf16(bf[nn], xf0, acc[0][nt], 0, 0, 0);
                    acc[1][nt] = __builtin_amdgcn_mfma_f32_16x16x32_bf16(bf[nn], xf1, acc[1][nt], 0, 0, 0); } }
        }
        const int h = g * 8 + pass * 4 + hh; float* sp = P.states() + (size_t)(bc * 32 + h) * 8192;
#pragma unroll
        for (int pt = 0; pt < 2; ++pt)
#pragma unroll
            for (int nt = 0; nt < 8; ++nt) *(f32x4*)(sp + ((2 * ph + pt) * 16 + fr) * 128 + nt * 16 + 4 * fq) = acc[pt][nt];
        __syncthreads();
    }
}

__device__ __forceinline__ void phase_scan(const Params& P) {
    const int gtid = blockIdx.x * 512 + opq(threadIdx.x), gsz = gridDim.x * 512;
    for (int it0 = gtid; it0 < 2 * 32 * 2048; it0 += gsz) {
        int it = it0;
        if (gsz == 256 * 512) { const int w = it0 >> 9, t = it0 & 511, xcd = w & 7, k = w >> 3, idx = k * 512 + t; it = ((((xcd & 1) * 32) + (xcd >> 1) * 8 + (idx >> 11)) << 11) | (idx & 2047); }
        const int e4 = it & 2047, bh = it >> 11, b = bh >> 5, h = bh & 31;
        f32x4 carry = (f32x4){0.f, 0.f, 0.f, 0.f};
#pragma unroll 1
        for (int cb = 0; cb < 32; cb += 8) {
            f32x4 st[8]; float dec[8];
#pragma unroll
            for (int k = 0; k < 8; ++k) { const size_t idx = (size_t)((b * 32 + cb + k) * 32 + h); st[k] = *(const f32x4*)(P.states() + idx * 8192 + e4 * 4); dec[k] = P.decay()[idx]; }
            __builtin_amdgcn_sched_barrier(0);
#pragma unroll
            for (int k = 0; k < 8; ++k) { const size_t idx = (size_t)((b * 32 + cb + k) * 32 + h);
                u32x2 o; o.x = pk2(carry[0], carry[1]); o.y = pk2(carry[2], carry[3]);
                *(u32x2*)(P.prev() + idx * 8192 + e4 * 4) = o;
                carry = carry * dec[k] + st[k]; }
        }
    }
}

__device__ __forceinline__ void ssd_out_unit(const Params& P, int L, int unit, LAS unsigned char* lds) {
    const int tid = opq(threadIdx.x), lane = tid & 63, w = tid >> 6, fr0 = lane & 15, fq0 = lane >> 4;
    const int g = unit & 3, bc = unit >> 2, m0 = bc * 128;
    LAS unsigned char* Cm = lds; LAS unsigned char* Bm = lds + 34816;
    LAS unsigned char* X = lds;
    LAS float* acum = (LAS float*)(lds + 131072); LAS float* dts = (LAS float*)(lds + 135168); LAS float* red = (LAS float*)(lds + 139264);
    ssd_dt_scan(P, L, m0, g, bc, acum, dts, 1);
#pragma unroll
    for (int it = 0; it < 4; ++it) { const int idx = it * 512 + tid, row = idx >> 4, c = idx & 15;
        const bf16_t* rp = P.xbc() + (size_t)(m0 + row) * 3072 + 2048 + g * 128 + c * 8;
        *(LAS u32x4*)(Bm + row * 272 + c * 16) = *(const u32x4*)(rp); *(LAS u32x4*)(Cm + row * 272 + c * 16) = *(const u32x4*)(rp + 512); }
    __syncthreads();
    const int pair = w & 3, hq = w >> 2, lt0 = pair, lt1 = 7 - pair;
    f32x4 cb0[4], cb1[8];
#pragma unroll
    for (int i = 0; i < 4; ++i) cb0[i] = (f32x4){0.f, 0.f, 0.f, 0.f};
#pragma unroll
    for (int i = 0; i < 8; ++i) cb1[i] = (f32x4){0.f, 0.f, 0.f, 0.f};
    bf16x8 cfr[2][4];
    {
        const LAS unsigned char* cr0 = Cm + (lt0 * 16 + fr0) * 272 + fq0 * 16; const LAS unsigned char* cr1 = Cm + (lt1 * 16 + fr0) * 272 + fq0 * 16;
#pragma unroll
        for (int ks = 0; ks < 4; ++ks) { cfr[0][ks] = *(const LAS bf16x8*)(cr0 + ks * 64); cfr[1][ks] = *(const LAS bf16x8*)(cr1 + ks * 64); }
    }
    const LAS unsigned char* br = Bm + fr0 * 272 + fq0 * 16;
#pragma unroll
    for (int ks = 0; ks < 4; ++ks) {
#pragma unroll
        for (int S = 0; S < 8; ++S) { if (S <= lt1) { const bf16x8 bfr = *(const LAS bf16x8*)(br + S * 16 * 272 + ks * 64);
                cb1[S] = __builtin_amdgcn_mfma_f32_16x16x32_bf16(bfr, cfr[1][ks], cb1[S], 0, 0, 0);
                if (S < 4) { if (S <= lt0) cb0[S < 4 ? S : 0] = __builtin_amdgcn_mfma_f32_16x16x32_bf16(bfr, cfr[0][ks], cb0[S < 4 ? S : 0], 0, 0, 0); } } }
    }
    __syncthreads();
#pragma unroll
    for (int it = 0; it < 16; ++it) { const int idx = it * 512 + tid, row = idx >> 6, c = idx & 63, e = c >> 3, p8 = (c & 7) * 8;
        *(LAS u32x4*)(X + e * 16384 + row * 128 + p8 * 2) = *(const u32x4*)(P.xbc() + (size_t)(m0 + row) * 3072 + g * 512 + c * 8); }
    __syncthreads();
#pragma unroll
    for (int lo = 0; lo < 2; ++lo) {
        const int li = 1 - lo;
        const int lane_ = opq(lane), fr = lane_ & 15, fq = lane_ >> 4, q = fr >> 2, pp = lane_ & 3;
        const int lt = li ? lt1 : lt0, l = lt * 16 + fr; const size_t m = (size_t)(m0 + l);
        f32x4 acc[4][4];
#pragma unroll
        for (int i = 0; i < 4; ++i)
#pragma unroll
            for (int pt = 0; pt < 4; ++pt) acc[i][pt] = (f32x4){0.f, 0.f, 0.f, 0.f};
#pragma unroll
        for (int i = 0; i < 4; ++i) { const int e = hq * 4 + i, h = g * 8 + e; const bf16_t* pv = P.prev() + (size_t)(bc * 32 + h) * 8192;
            bf16x8 pf[16];
            asm volatile("" ::: "memory");
#pragma unroll
            for (int ks = 0; ks < 4; ++ks)
#pragma unroll
                for (int pt = 0; pt < 4; ++pt) pf[ks * 4 + pt] = *(const bf16x8*)(pv + (32 * (pt >> 1) + 8 * (fr >> 2) + 4 * (pt & 1) + (fr & 3)) * 128 + ks * 32 + fq * 8);
            __builtin_amdgcn_sched_barrier(0);
#pragma unroll
            for (int ks = 0; ks < 4; ++ks)
#pragma unroll
                for (int pt = 0; pt < 4; ++pt) acc[i][pt] = __builtin_amdgcn_mfma_f32_16x16x32_bf16(pf[ks * 4 + pt], cfr[li][ks], acc[i][pt], 0, 0, 0);
            const float sc = __expf(acum[e * 128 + l]);
#pragma unroll
            for (int pt = 0; pt < 4; ++pt) acc[i][pt] *= sc;
        }
#pragma unroll
        for (int i = 0; i < 4; ++i) { const int e = hq * 4 + i;
            const unsigned xb = lds_addr(X) + e * 16384 + (4 * fq + q) * 128 + (8 * pp) * 2;
            const float al = acum[e * 128 + l];
#pragma unroll
            for (int u = 0; u < (li ? 4 : 2); ++u) { if (2 * u <= lt) {
                    float gv[8];
#pragma unroll
                    for (int t = 0; t < 2; ++t) { const int S = 2 * u + t; const f32x4 cbt = li ? cb1[S] : cb0[S < 4 ? S : 0];
                        const f32x4 as = *(const LAS f32x4*)(acum + e * 128 + S * 16 + 4 * fq), ds = *(const LAS f32x4*)(dts + e * 128 + S * 16 + 4 * fq);
#pragma unroll
                        for (int j = 0; j < 4; ++j) { const int s = S * 16 + 4 * fq + j; const float v = cbt[j] * __expf(al - as[j]) * ds[j]; gv[4 * t + j] = (s <= l) ? v : 0.f; } }
                    const bf16x8 gf = __builtin_bit_cast(bf16x8, pack8(gv));
                    bf16x8 xf[4]; tr_frag4o<2048, 8, 64, 72>(xb + u * 4096, xf);
#pragma unroll
                    for (int pt = 0; pt < 4; ++pt) acc[i][pt] = __builtin_amdgcn_mfma_f32_16x16x32_bf16(xf[pt], gf, acc[i][pt], 0, 0, 0); } }
        }
        float ss = 0.f;
        u32x4 zz[8];
        asm volatile("" ::: "memory");
#pragma unroll
        for (int i = 0; i < 4; ++i)
#pragma unroll
            for (int k = 0; k < 2; ++k) zz[i * 2 + k] = *(const u32x4*)(P.proj() + m * NPROJ + 2048 + g * 512 + (hq * 4 + i) * 64 + 32 * k + 8 * fq);
        __builtin_amdgcn_sched_barrier(0);
#pragma unroll
        for (int i = 0; i < 4; ++i) { const int e = hq * 4 + i, h = g * 8 + e; const float Dk = P.ssm_d[L * 32 + h];
#pragma unroll
            for (int k = 0; k < 2; ++k) { const int p = 32 * k + 8 * fq;
                float xf_[8], zf[8]; unpack8(*(const LAS u32x4*)(X + e * 16384 + l * 128 + p * 2), xf_); unpack8(zz[i * 2 + k], zf);
#pragma unroll
                for (int j = 0; j < 4; ++j) { const float v0 = (acc[i][2 * k][j] + xf_[j] * Dk) * siluf_(zf[j]), v1 = (acc[i][2 * k + 1][j] + xf_[4 + j] * Dk) * siluf_(zf[4 + j]);
                    acc[i][2 * k][j] = v0; acc[i][2 * k + 1][j] = v1; ss += v0 * v0 + v1 * v1; } } }
        ss += __shfl_xor(ss, 16); ss += __shfl_xor(ss, 32);
        if (fq == 0) red[hq * 128 + l] = ss;
        __syncthreads();
        const float r = rsqrtf((red[l] + red[128 + l]) * (1.f / 512.f) + EPS);
#pragma unroll
        for (int i = 0; i < 4; ++i) { const int e = hq * 4 + i; if ((i & 1) == 0) asm volatile("" ::: "memory");
#pragma unroll
            for (int k = 0; k < 2; ++k) { const int ch = g * 512 + e * 64 + 32 * k + 8 * fq;
                const f32x4 nw0 = *(const f32x4*)(P.ssm_norm_w + (size_t)L * 2048 + ch), nw1 = *(const f32x4*)(P.ssm_norm_w + (size_t)L * 2048 + ch + 4);
                const f32x4 va = acc[i][2 * k], vb = acc[i][2 * k + 1];
                u32x4 o; o.x = pk2(va[0] * r * nw0[0], va[1] * r * nw0[1]); o.y = pk2(va[2] * r * nw0[2], va[3] * r * nw0[3]);
                o.z = pk2(vb[0] * r * nw1[0], vb[1] * r * nw1[1]); o.w = pk2(vb[2] * r * nw1[2], vb[3] * r * nw1[3]);
                *(u32x4*)(P.act() + m * 4096 + 1024 + ch) = o; } }
    }
    __syncthreads();
}


#define XB_TMO      128
#define XB_XCNT(j)  (256  + 64 * (j))
#define XB_XSUB(j)  (1280 + 64 * (j))
#define XB_XGEN(j)  (2304 + 64 * (j))
#define XB_TOP      3328
#define XB_TOPGEN   3392
#define XCD_BAR_WORDS 3456
#define XB_SPIN_CAP (1u << 18)
__device__ __forceinline__ unsigned xb_ld(unsigned* p)              { return __hip_atomic_load(p, __ATOMIC_RELAXED, __HIP_MEMORY_SCOPE_AGENT); }
__device__ __forceinline__ unsigned xb_add(unsigned* p, unsigned v) { return __hip_atomic_fetch_add(p, v, __ATOMIC_RELAXED, __HIP_MEMORY_SCOPE_AGENT); }
__device__ __forceinline__ unsigned xb_xcc_id() { return (unsigned)__builtin_amdgcn_s_getreg((3 << 11) | 20) & 0xFu; }
#define XB_SPIN(cond, bar) do { unsigned _sp = 0; while (cond) { __builtin_amdgcn_s_sleep(1); \
    if ((++_sp & 255u) == 0u) { if (xb_ld(&(bar)[XB_TMO])) break; if (_sp > XB_SPIN_CAP) { atomicAdd(&(bar)[XB_TMO], 1u); break; } } } } while (0)
struct XcdBarrier { unsigned* bar; unsigned x; volatile LAS unsigned* st; };
__device__ __forceinline__ XcdBarrier xcd_barrier_post(unsigned* bar, volatile LAS unsigned* st) {
    XcdBarrier b; b.bar = bar; b.x = xb_xcc_id(); b.st = st;
    if (threadIdx.x == 0) (void)xb_add(&bar[XB_XCNT(b.x)], 1u);
    return b;
}
__device__ __forceinline__ void xcd_barrier_complete(unsigned* bar, unsigned x, unsigned& nloc, unsigned& nx) {
    const unsigned G = gridDim.x * gridDim.y * gridDim.z;
    unsigned sum, cnt, mine, sp = 0u;
    for (;;) {
        sum = 0u; cnt = 0u; mine = 0u;
#pragma unroll
        for (unsigned j = 0; j < 16; ++j) { const unsigned c = xb_ld(&bar[XB_XCNT(j)]); sum += c; cnt += (c > 0u) ? 1u : 0u; mine = (j == x) ? c : mine; }
        if (sum == G) break;
        __builtin_amdgcn_s_sleep(1);
        if ((++sp & 255u) == 0u) { if (xb_ld(&bar[XB_TMO])) break; if (sp > XB_SPIN_CAP) { atomicAdd(&bar[XB_TMO], 1u); break; } }
    }
    nloc = mine > 0u ? mine : 1u; nx = cnt > 0u ? cnt : 1u;
}
__device__ __forceinline__ void xcd_barrier(const XcdBarrier& b) {
    asm volatile("s_waitcnt vmcnt(0)" ::: "memory");
    __syncthreads();
    if (threadIdx.x == 0) {
        unsigned* bar = b.bar;
        __builtin_amdgcn_s_waitcnt(0);
        unsigned nloc = b.st[0], nx = b.st[1];
        if (nloc == 0u) { xcd_barrier_complete(bar, b.x, nloc, nx); b.st[0] = nloc; b.st[1] = nx; }
        const unsigned old = xb_add(&bar[XB_XSUB(b.x)], 1u);
        const unsigned gen = old / nloc;
        if (old + 1u == (gen + 1u) * nloc) {
            __builtin_amdgcn_fence(__ATOMIC_RELEASE, "agent");
            asm volatile("s_waitcnt vmcnt(0)" ::: "memory");
            const unsigned og = xb_add(&bar[XB_TOP], 1u);
            const unsigned tg = og / nx;
            if (og + 1u == (tg + 1u) * nx) xb_add(&bar[XB_TOPGEN], 1u);
            else XB_SPIN(xb_ld(&bar[XB_TOPGEN]) == tg, bar);
            __builtin_amdgcn_fence(__ATOMIC_ACQUIRE, "agent");
            xb_add(&bar[XB_XGEN(b.x)], 1u);
            asm volatile("s_waitcnt vmcnt(0)" ::: "memory");
        } else {
            XB_SPIN(xb_ld(&bar[XB_XGEN(b.x)]) == gen, bar);
            __builtin_amdgcn_fence(__ATOMIC_ACQUIRE, "agent");
            asm volatile("s_waitcnt vmcnt(0)" ::: "memory");
        }
    }
    __syncthreads();
}

#ifndef REP_CVT
#define REP_CVT 1
#endif
#ifndef REP_NORM
#define REP_NORM 1
#endif
#ifndef REP_GIN
#define REP_GIN 1
#endif
#ifndef REP_PREP
#define REP_PREP 1
#endif
#ifndef REP_SSD
#define REP_SSD 1
#endif
#ifndef REP_GGRP
#define REP_GGRP 1
#endif
#ifndef REP_GBR
#define REP_GBR 1
#endif
#ifndef REP_GOUT
#define REP_GOUT 1
#endif
#ifndef REP_SYNC
#define REP_SYNC 1
#endif
#define GSYNC() do { for (int r_ = 0; r_ < REP_SYNC; ++r_) xcd_barrier(xb); } while (0)
__global__ void __launch_bounds__(512, 2) hybrid_fwd(Params P) {
    extern __shared__ __attribute__((aligned(16))) unsigned char shm_[];
    LAS unsigned char* lds = (LAS unsigned char*)shm_;
    cg::grid_group grid = cg::this_grid();
    const int G = (int)gridDim.x, c = (int)blockIdx.x;
    volatile LAS unsigned* xst = (volatile LAS unsigned*)(lds + LDS_BYTES - 16);
    if (threadIdx.x == 0) { xst[0] = 0u; xst[1] = 0u; xst[2] = 0u; xst[3] = 0u; }
    __syncthreads();
    const XcdBarrier xb = xcd_barrier_post(P.bar(), xst);
    for (int r = 0; r < REP_CVT; ++r) phase_convert(P, lds);
    phase_rmsnorm(P.x, P.norm_w, P.h(), nullptr, P.rowsq());
    grid.sync();
    GSYNC();
#pragma unroll 1
    for (int L = 0; L < 4; ++L) {
        const float* xin = L == 0 ? P.x : P.xcur();
        for (int r = 0; r < REP_GIN; ++r)
        { { const int t_ = opq(threadIdx.x); const float* bgp = P.b_gate + (size_t)L * 6144 + t_ * 12;
            const f32x4 b0 = *(const f32x4*)bgp, b1 = *(const f32x4*)(bgp + 4), b2 = *(const f32x4*)(bgp + 8);
            LAS u32x2* bl = (LAS u32x2*)(lds + 131072 + t_ * 24);
            u32x2 o0, o1, o2; o0.x = pk2(b0[0], b0[1]); o0.y = pk2(b0[2], b0[3]); o1.x = pk2(b1[0], b1[1]); o1.y = pk2(b1[2], b1[3]); o2.x = pk2(b2[0], b2[1]); o2.y = pk2(b2[2], b2[3]);
            bl[0] = o0; bl[1] = o1; bl[2] = o2;
            LAS _Float16* lr = (LAS _Float16*)(lds + 143360);
#pragma unroll
            for (int k = 0; k < 4; ++k) { const f32x4 q = *(const f32x4*)(P.rowsq() + t_ * 16 + k * 4);
#pragma unroll
                for (int j = 0; j < 4; ++j) lr[t_ * 16 + k * 4 + j] = (_Float16)rsqrtf(q[j] * (1.f / DM) + EPS); }
            __syncthreads(); }
          { Gemm g; g.A = P.h(); g.Bt = P.bt_in() + (size_t)L * NIN_PAD * DM; g.lda = DM; g.ldb = DM; g.K = DM; g.nM = 32; g.nN = 69; g.a_pn_off = 0;
            StaticOrder S; S.init(32, 69, G, c); EpiInProjU E; E.proj = P.proj(); E.dt = P.dt(); E.gates = P.gates(); E.lbias = lds + 131072; E.lrstd = (LAS const _Float16*)(lds + 143360);
            gemm_phase<EpiInProjU, true>(lds, g, S, E); } }
        GSYNC();
        for (int r = 0; r < REP_PREP; ++r) phase_prep(P, L);
        GSYNC();
        const bool split = (G == 256);
        for (int r = 0; r < REP_SSD; ++r) { if (split) { if (c < 128) { const int xcd = c & 7, k2 = c >> 3, ub = ((xcd & 1) * 32 + 2 * k2) * 4 + (xcd >> 1); ssd_states_unit(P, L, ub, lds); ssd_states_unit(P, L, ub + 4, lds); } } else for (int u = c; u < 256; u += G) ssd_states_unit(P, L, u, lds); }
        for (int r = 0; r < REP_GGRP; ++r)
        { Gemm g; g.A = P.dpool(); g.Bt = P.bt_grp() + (size_t)L * 1024 * 256; g.lda = 1024; g.ldb = 256; g.K = 256; g.nM = 32; g.nN = 4; g.a_pn_off = 256;
          StaticOrder S; if (split) S.init(32, 4, 128, c >= 128 ? c - 128 : 1 << 20); else S.init(32, 4, G, c); EpiGrp E; E.act = P.act(); E.gates = P.gates(); E.scale = P.pool_scale + (size_t)L * 1024;
          gemm_phase(lds, g, S, E); }
        GSYNC();
        for (int r = 0; r < REP_SSD; ++r) phase_scan(P);
        GSYNC();
        for (int r = 0; r < REP_SSD; ++r) { if (split) ssd_out_unit(P, L, ((c & 1) * 32 + (c >> 3)) * 4 + ((c & 7) >> 1), lds); else for (int u = c; u < 256; u += G) ssd_out_unit(P, L, u, lds); }
        GSYNC();
        for (int r = 0; r < REP_GBR; ++r)
        { Gemm g; g.A = P.act(); g.Bt = P.bt_br() + (size_t)L * DM * 4096; g.lda = 4096; g.ldb = 4096; g.K = 4096; g.nM = 32; g.nN = 8; g.a_pn_off = 0;
          StaticOrder S; S.init(32, 8, G, c); EpiBr E; E.merged = P.merged(); E.gates = P.gates();
          gemm_phase(lds, g, S, E); }
        GSYNC();
        for (int r = 0; r < REP_GOUT; ++r)
        { Gemm g; g.A = P.merged(); g.Bt = P.bt_out() + (size_t)L * DM * DM; g.lda = DM; g.ldb = DM; g.K = DM; g.nM = 32; g.nN = 8; g.a_pn_off = 0;
          StaticOrder S; S.init(32, 8, G, c); EpiOut E; E.xin = xin; E.xout = (r == REP_GOUT - 1) ? P.xcur() : P.states(); E.nw_next = (L < 3) ? P.norm_w + (size_t)(L + 1) * DM : nullptr; E.hout = P.h(); E.rowsq = P.rowsq();
          gemm_phase(lds, g, S, E); }
        GSYNC();
    }
    phase_rmsnorm(P.xcur(), P.final_norm_w, nullptr, P.out);
}

extern "C" void kernel_launch(void* const* d_in, const int* in_sizes, int n_in, void* d_out, int out_size, void* d_ws, size_t ws_size, hipStream_t stream) {
    static int grid_blocks = 0;
    if (!grid_blocks) {
        int dev = 0, cus = 0, per_cu = 0;
        hipGetDevice(&dev);
        hipDeviceGetAttribute(&cus, hipDeviceAttributeMultiprocessorCount, dev);
        if (hipFuncSetAttribute((const void*)hybrid_fwd, hipFuncAttributeMaxDynamicSharedMemorySize, LDS_BYTES) != hipSuccess) fprintf(stderr, "hipFuncSetAttribute failed\n");
        if (hipOccupancyMaxActiveBlocksPerMultiprocessor(&per_cu, (const void*)hybrid_fwd, 512, LDS_BYTES) != hipSuccess || per_cu < 1) { fprintf(stderr, "occupancy query gave %d\n", per_cu); per_cu = 1; }
        (void)hipGetLastError();
        grid_blocks = cus * per_cu;
        if (grid_blocks > 256) grid_blocks = 256;
    }
    Params p{};
    const float* const* in = (const float* const*)d_in;
    p.x = in[0]; p.norm_w = in[1]; p.w_in = in[2]; p.b_gate = in[3]; p.pool_w = in[4]; p.pool_scale = in[5]; p.ssm_conv_w = in[6]; p.ssm_conv_b = in[7];
    p.ssm_dt_bias = in[8]; p.ssm_a_log = in[9]; p.ssm_d = in[10]; p.ssm_norm_w = in[11]; p.sc_conv_w = in[12]; p.w_br_pool = in[13]; p.w_br_ssm = in[14];
    p.w_br_conv = in[15]; p.w_out = in[16]; p.final_norm_w = in[17];
    p.out = (float*)d_out;
    p.ws = (unsigned char*)d_ws;
    if (WS_END > ws_size) { fprintf(stderr, "workspace too small: need %zu have %zu\n", (size_t)WS_END, ws_size); return; }
    if (hipMemsetAsync((unsigned char*)d_ws + OFF_BAR, 0, 16384, stream) != hipSuccess) { fprintf(stderr, "memset of barrier words failed\n"); return; }
    void* args[] = {&p};
    hipError_t e = hipLaunchCooperativeKernel((const void*)hybrid_fwd, dim3(grid_blocks), dim3(512), args, LDS_BYTES, stream);
    if (e != hipSuccess) fprintf(stderr, "cooperative launch failed: %s (grid %d)\n", hipGetErrorString(e), grid_blocks);
}
```

```cpp
#include <hip/hip_runtime.h>
#include <hip/hip_cooperative_groups.h>
#include <cstdio>
#include <cstdint>
namespace cg = cooperative_groups;

#define LAS __attribute__((address_space(3)))
typedef unsigned short bf16_t;
typedef short bf16x8 __attribute__((ext_vector_type(8)));
typedef float f32x4 __attribute__((ext_vector_type(4)));
typedef unsigned u32x4 __attribute__((ext_vector_type(4)));
typedef unsigned u32x2 __attribute__((ext_vector_type(2)));

constexpr int M_TOK = 8192, DM = 2048, NPROJ = 17408, NIN_PAD = 17664, NIN_SRC = 17440;
constexpr int LDS_BYTES = 163840;
constexpr float EPS = 1e-6f;

constexpr size_t al256(size_t b) { return (b + 255) & ~(size_t)255; }
constexpr size_t OFF_BT_IN = 0;
constexpr size_t OFF_BT_GRP = OFF_BT_IN + al256((size_t)4 * NIN_PAD * DM * 2);
constexpr size_t OFF_BT_BR = OFF_BT_GRP + al256((size_t)4 * 1024 * 256 * 2);
constexpr size_t OFF_BT_OUT = OFF_BT_BR + al256((size_t)4 * DM * 4096 * 2);
constexpr size_t OFF_XCUR = OFF_BT_OUT + al256((size_t)4 * DM * DM * 2);
constexpr size_t OFF_H = OFF_XCUR + al256((size_t)M_TOK * DM * 4);
constexpr size_t OFF_PROJ = OFF_H + al256((size_t)M_TOK * DM * 2);
constexpr size_t OFF_DT = OFF_PROJ + al256((size_t)M_TOK * NPROJ * 2);
constexpr size_t OFF_DPOOL = OFF_DT + al256((size_t)M_TOK * 32 * 4);
constexpr size_t OFF_XBC = OFF_DPOOL + al256((size_t)M_TOK * 1024 * 2);
constexpr size_t OFF_ACT = OFF_XBC + al256((size_t)M_TOK * 3072 * 2);
constexpr size_t OFF_STATES = OFF_ACT + al256((size_t)M_TOK * 4096 * 2);
constexpr size_t OFF_PREV = OFF_STATES + al256((size_t)64 * 32 * 8192 * 4);
constexpr size_t OFF_DECAY = OFF_PREV + al256((size_t)64 * 32 * 8192 * 2);
constexpr size_t OFF_MERGED = OFF_DECAY + al256((size_t)64 * 32 * 4);
constexpr size_t OFF_GATES = OFF_MERGED + al256((size_t)M_TOK * DM * 2);
constexpr size_t OFF_BAR = OFF_GATES + al256((size_t)4 * M_TOK * DM * 2);
constexpr size_t OFF_ROWSQ = OFF_BAR + 16384;
constexpr size_t WS_END = OFF_ROWSQ + 32768;

struct Params {
    const float *x, *norm_w, *w_in, *b_gate, *pool_w, *pool_scale, *ssm_conv_w, *ssm_conv_b, *ssm_dt_bias, *ssm_a_log, *ssm_d,
        *ssm_norm_w, *sc_conv_w, *w_br_pool, *w_br_ssm, *w_br_conv, *w_out, *final_norm_w;
    float* out;
    unsigned char* ws;
    __device__ __forceinline__ bf16_t* bt_in() const { return (bf16_t*)(ws + OFF_BT_IN); }
    __device__ __forceinline__ bf16_t* bt_grp() const { return (bf16_t*)(ws + OFF_BT_GRP); }
    __device__ __forceinline__ bf16_t* bt_br() const { return (bf16_t*)(ws + OFF_BT_BR); }
    __device__ __forceinline__ bf16_t* bt_out() const { return (bf16_t*)(ws + OFF_BT_OUT); }
    __device__ __forceinline__ float* xcur() const { return (float*)(ws + OFF_XCUR); }
    __device__ __forceinline__ bf16_t* h() const { return (bf16_t*)(ws + OFF_H); }
    __device__ __forceinline__ bf16_t* proj() const { return (bf16_t*)(ws + OFF_PROJ); }
    __device__ __forceinline__ float* dt() const { return (float*)(ws + OFF_DT); }
    __device__ __forceinline__ bf16_t* dpool() const { return (bf16_t*)(ws + OFF_DPOOL); }
    __device__ __forceinline__ bf16_t* xbc() const { return (bf16_t*)(ws + OFF_XBC); }
    __device__ __forceinline__ bf16_t* act() const { return (bf16_t*)(ws + OFF_ACT); }
    __device__ __forceinline__ float* states() const { return (float*)(ws + OFF_STATES); }
    __device__ __forceinline__ bf16_t* prev() const { return (bf16_t*)(ws + OFF_PREV); }
    __device__ __forceinline__ float* decay() const { return (float*)(ws + OFF_DECAY); }
    __device__ __forceinline__ bf16_t* merged() const { return (bf16_t*)(ws + OFF_MERGED); }
    __device__ __forceinline__ bf16_t* gates() const { return (bf16_t*)(ws + OFF_GATES); }
    __device__ __forceinline__ unsigned* bar() const { return (unsigned*)(ws + OFF_BAR); }
    __device__ __forceinline__ float* rowsq() const { return (float*)(ws + OFF_ROWSQ); }
};

__device__ __forceinline__ unsigned pk2(float lo, float hi) { unsigned r; asm volatile("v_cvt_pk_bf16_f32 %0, %1, %2" : "=v"(r) : "v"(lo), "v"(hi)); return r; }
__device__ __forceinline__ float bflo(unsigned v) { return __uint_as_float(v << 16); }
__device__ __forceinline__ float bfhi(unsigned v) { return __uint_as_float(v & 0xffff0000u); }
__device__ __forceinline__ void unpack8(const u32x4 v, float (&f)[8]) {
    f[0] = bflo(v.x); f[1] = bfhi(v.x); f[2] = bflo(v.y); f[3] = bfhi(v.y); f[4] = bflo(v.z); f[5] = bfhi(v.z); f[6] = bflo(v.w); f[7] = bfhi(v.w);
}
__device__ __forceinline__ u32x4 pack8(const float (&f)[8]) { u32x4 o; o.x = pk2(f[0], f[1]); o.y = pk2(f[2], f[3]); o.z = pk2(f[4], f[5]); o.w = pk2(f[6], f[7]); return o; }
__device__ __forceinline__ float sigmoidf_(float v) { return __builtin_amdgcn_rcpf(1.f + __builtin_amdgcn_exp2f(-1.44269504f * v)); }
__device__ __forceinline__ float siluf_(float v) { return v * __builtin_amdgcn_rcpf(1.f + __builtin_amdgcn_exp2f(-1.44269504f * v)); }
__device__ __forceinline__ float softplusf_(float v) { return v > 20.f ? v : log1pf(expf(v)); }
__device__ __forceinline__ float wave_sum(float v) {
#pragma unroll
    for (int o = 1; o < 64; o <<= 1) v += __shfl_xor(v, o);
    return v;
}
__device__ __forceinline__ float wave_scan_incl(float v, int lane) {
#pragma unroll
    for (int o = 1; o < 64; o <<= 1) { const float t = __shfl_up(v, o); if (lane >= o) v += t; }
    return v;
}
__device__ __forceinline__ int opq(int v) { asm volatile("" : "+v"(v)); return v; }
__device__ __forceinline__ unsigned lds_addr(LAS const void* p) { return (unsigned)(uintptr_t)p; }
__device__ __forceinline__ bf16x8 mk_frag(u32x2 a, u32x2 b) { u32x4 r; r.x = a.x; r.y = a.y; r.z = b.x; r.w = b.y; return __builtin_bit_cast(bf16x8, r); }
template <int OFF2>
__device__ __forceinline__ bf16x8 tr_frag(unsigned addr) {
    u32x2 a, b;
    asm volatile("ds_read_b64_tr_b16 %0, %2\n\tds_read_b64_tr_b16 %1, %2 offset:%3\n\ts_waitcnt lgkmcnt(0)" : "=&v"(a), "=&v"(b) : "v"(addr), "n"(OFF2) : "memory");
    return mk_frag(a, b);
}
template <int OFF2, int STRIDE>
__device__ __forceinline__ void tr_frag2(unsigned addr, bf16x8& f0, bf16x8& f1) {
    u32x2 a0, b0, a1, b1;
    asm volatile("ds_read_b64_tr_b16 %0, %4\n\tds_read_b64_tr_b16 %1, %4 offset:%5\n\tds_read_b64_tr_b16 %2, %4 offset:%6\n\tds_read_b64_tr_b16 %3, %4 offset:%7\n\ts_waitcnt lgkmcnt(0)"
                 : "=&v"(a0), "=&v"(b0), "=&v"(a1), "=&v"(b1) : "v"(addr), "n"(OFF2), "n"(STRIDE), "n"(STRIDE + OFF2) : "memory");
    f0 = mk_frag(a0, b0); f1 = mk_frag(a1, b1);
}
template <int OFF2, int STRIDE>
__device__ __forceinline__ void tr_frag4(unsigned addr, bf16x8 (&f)[4]) {
    u32x2 a0, b0, a1, b1, a2, b2, a3, b3;
    asm volatile("ds_read_b64_tr_b16 %0, %8\n\tds_read_b64_tr_b16 %1, %8 offset:%9\n\tds_read_b64_tr_b16 %2, %8 offset:%10\n\tds_read_b64_tr_b16 %3, %8 offset:%11\n\t"
                 "ds_read_b64_tr_b16 %4, %8 offset:%12\n\tds_read_b64_tr_b16 %5, %8 offset:%13\n\tds_read_b64_tr_b16 %6, %8 offset:%14\n\tds_read_b64_tr_b16 %7, %8 offset:%15\n\ts_waitcnt lgkmcnt(0)"
                 : "=&v"(a0), "=&v"(b0), "=&v"(a1), "=&v"(b1), "=&v"(a2), "=&v"(b2), "=&v"(a3), "=&v"(b3)
                 : "v"(addr), "n"(OFF2), "n"(STRIDE), "n"(STRIDE + OFF2), "n"(2 * STRIDE), "n"(2 * STRIDE + OFF2), "n"(3 * STRIDE), "n"(3 * STRIDE + OFF2) : "memory");
    f[0] = mk_frag(a0, b0); f[1] = mk_frag(a1, b1); f[2] = mk_frag(a2, b2); f[3] = mk_frag(a3, b3);
}

template <int OFF2, int O1, int O2, int O3>
__device__ __forceinline__ void tr_frag4o(unsigned addr, bf16x8 (&f)[4]) {
    u32x2 a0, b0, a1, b1, a2, b2, a3, b3;
    asm volatile("ds_read_b64_tr_b16 %0, %8\n\tds_read_b64_tr_b16 %1, %8 offset:%9\n\tds_read_b64_tr_b16 %2, %8 offset:%10\n\tds_read_b64_tr_b16 %3, %8 offset:%11\n\t"
                 "ds_read_b64_tr_b16 %4, %8 offset:%12\n\tds_read_b64_tr_b16 %5, %8 offset:%13\n\tds_read_b64_tr_b16 %6, %8 offset:%14\n\tds_read_b64_tr_b16 %7, %8 offset:%15\n\ts_waitcnt lgkmcnt(0)"
                 : "=&v"(a0), "=&v"(b0), "=&v"(a1), "=&v"(b1), "=&v"(a2), "=&v"(b2), "=&v"(a3), "=&v"(b3)
                 : "v"(addr), "n"(OFF2), "n"(O1), "n"(O1 + OFF2), "n"(O2), "n"(O2 + OFF2), "n"(O3), "n"(O3 + OFF2) : "memory");
    f[0] = mk_frag(a0, b0); f[1] = mk_frag(a1, b1); f[2] = mk_frag(a2, b2); f[3] = mk_frag(a3, b3);
}

constexpr int BM = 256, BK = 64, HALF = 128, HTB = HALF * BK * 2, NXCD = 8, WGM = 8;
__device__ __forceinline__ int lds_byte(int r, int c) { const int st = (r >> 4) * 2 + (c >> 5), rr = r & 15, cc = c & 31, ob = rr * 64 + cc * 2; return st * 1024 + (ob ^ (((ob >> 9) & 1) << 5)); }
__device__ __forceinline__ void stage_rc(int b, int& R, int& C) { const int st = b / 1024, sb = b % 1024, swz = sb ^ (((sb >> 9) & 1) << 5); R = (st >> 1) * 16 + swz / 64; C = (st & 1) * 32 + (swz % 64) / 2; }
__device__ __forceinline__ int perm32(int rho) { const int n = rho >> 4, i = rho & 15; return 8 * (i >> 2) + 4 * n + (i & 3); }

struct Unit { int pm, pn; };
struct Gemm { const bf16_t* A; const bf16_t* Bt; int lda, ldb, K, nM, nN, a_pn_off; };
struct StaticOrder {
    int nM, nN, nwg, G, c;
    __device__ void init(int nM_, int nN_, int G_, int c_) { nM = nM_; nN = nN_; nwg = nM * nN; G = G_; c = c_; }
    __device__ bool next(int i, Unit& u) const {
        const long L = (long)i * G + c; if (L >= nwg) return false;
        int wgid = (int)L; { const int q = nwg / NXCD, r = nwg % NXCD, xcd = wgid % NXCD, off = wgid / NXCD; wgid = (xcd < r ? xcd * (q + 1) : r * (q + 1) + (xcd - r) * q) + off; }
        const int nig = WGM * nN, gid = wgid / nig, fm = gid * WGM, gsz = (nM - fm) < WGM ? (nM - fm) : WGM;
        u.pm = fm + ((wgid % nig) % gsz); u.pn = (wgid % nig) / gsz; return true;
    }
};

template <class Epi, bool ALIGN_EPI = false, bool SP2 = true>
__device__ __forceinline__ void gemm_phase(LAS unsigned char* lds, const Gemm g, const StaticOrder& S, const Epi& E) {
    const int tid = opq(threadIdx.x), wid = __builtin_amdgcn_readfirstlane(tid >> 6), lane = tid & 63, wr = wid >> 2, wc = wid & 3, fr = lane & 15, fq = lane >> 4;
    int K_ = g.K; asm volatile("" : "+s"(K_)); const int K = K_, nt = K / BK;
    unsigned voffA[2], voffB[2];
#pragma unroll
    for (int i = 0; i < 2; ++i) { int R, C; stage_rc(tid * 16 + i * 8192, R, C); const int Rb = (R & ~31) + perm32(R & 31);
        voffA[i] = (unsigned)(R * g.lda + C) * 2u; voffB[i] = (unsigned)(Rb * g.ldb + C) * 2u; }
    const size_t kstep = (size_t)(BK * 2);
    const size_t hstepA = (size_t)HALF * g.lda * 2, hstepB = (size_t)HALF * g.ldb * 2;
    const size_t tstepA = 2 * hstepA, tstepB = 2 * hstepB;
    const unsigned ldsw = (unsigned)wid * 1024u;
    const int aoff = lds_byte(wr * 64 + fr, fq * 8), boff = lds_byte(wc * 32 + fr, fq * 8);
#define PG8_SA(b, h) (((b) * 2 + (h)) * HTB)
#define PG8_SB(b, h) ((4 + (b) * 2 + (h)) * HTB)
#define PG8_STAGE(bufoff, gbase, voff) do { _Pragma("unroll") for (int _i = 0; _i < 2; ++_i) \
        __builtin_amdgcn_global_load_lds((const unsigned*)((const char*)(gbase) + (voff)[_i]), (LAS unsigned*)(lds + (bufoff) + ldsw + _i * 8192), 16, 0, 0); } while (0)
#define PG8_LDA(dst, b, h) do { _Pragma("unroll") for (int m = 0; m < 4; ++m) _Pragma("unroll") for (int k = 0; k < 2; ++k) dst[m][k] = *(const LAS bf16x8*)(lds + PG8_SA(b, h) + aoff + m * 2048 + k * 1024); } while (0)
#define PG8_LDB(dst, b, h) do { _Pragma("unroll") for (int n = 0; n < 2; ++n) _Pragma("unroll") for (int k = 0; k < 2; ++k) dst[n][k] = *(const LAS bf16x8*)(lds + PG8_SB(b, h) + boff + n * 2048 + k * 1024); } while (0)
#define PG8_MMA(ai, bj, At, Bt) do { __builtin_amdgcn_s_setprio(1); _Pragma("unroll") for (int m = 0; m < 4; ++m) _Pragma("unroll") for (int n = 0; n < 2; ++n) _Pragma("unroll") for (int k = 0; k < 2; ++k) \
        acc[ai][bj][m][n] = __builtin_amdgcn_mfma_f32_16x16x32_bf16(Bt[n][k], At[m][k], acc[ai][bj][m][n], 0, 0, 0); __builtin_amdgcn_s_setprio(0); } while (0)
#define PG8_WAIT_V(n) asm volatile("s_waitcnt vmcnt(" #n ")" ::: "memory")
#define PG8_WAIT_L(n) asm volatile("s_waitcnt lgkmcnt(" #n ")" ::: "memory")
#define PG8_BAR __builtin_amdgcn_s_barrier()
#define PG8_SCHED __builtin_amdgcn_sched_barrier(0)
    Unit cur, nxt; int ui = 0;
    if (!S.next(0, cur)) return;
    f32x4 acc[2][2][4][2];
#pragma unroll
    for (int a = 0; a < 2; ++a)
#pragma unroll
        for (int b = 0; b < 2; ++b)
#pragma unroll
            for (int m = 0; m < 4; ++m)
#pragma unroll
                for (int n = 0; n < 2; ++n) acc[a][b][m][n] = (f32x4){0.f, 0.f, 0.f, 0.f};
    bf16x8 At[4][2], B0[2][2], B1[2][2];
    const char* cA = (const char*)g.A + (size_t)cur.pm * tstepA + (size_t)cur.pn * g.a_pn_off * 2; const char* cB = (const char*)g.Bt + (size_t)cur.pn * tstepB;
    if constexpr (SP2) {
        PG8_STAGE(PG8_SB(0, 0), cB, voffB); PG8_STAGE(PG8_SB(0, 1), cB + hstepB, voffB); PG8_STAGE(PG8_SA(0, 0), cA, voffA); PG8_STAGE(PG8_SA(0, 1), cA + hstepA, voffA);
        if (wr == 1) PG8_BAR;
        PG8_WAIT_V(2); PG8_BAR;
        PG8_STAGE(PG8_SB(1, 0), cB + kstep, voffB); PG8_STAGE(PG8_SA(1, 0), cA + kstep, voffA); PG8_STAGE(PG8_SB(1, 1), cB + hstepB + kstep, voffB);
        PG8_WAIT_V(6); PG8_BAR;
    } else {
    PG8_STAGE(PG8_SB(0, 0), cB, voffB); PG8_STAGE(PG8_SA(0, 0), cA, voffA); PG8_STAGE(PG8_SB(0, 1), cB + hstepB, voffB); PG8_STAGE(PG8_SA(0, 1), cA + hstepA, voffA);
    if (wr == 1) PG8_BAR;
    PG8_WAIT_V(4); PG8_BAR;
    PG8_STAGE(PG8_SB(1, 0), cB + kstep, voffB); PG8_STAGE(PG8_SA(1, 0), cA + kstep, voffA); PG8_STAGE(PG8_SB(1, 1), cB + hstepB + kstep, voffB);
    PG8_WAIT_V(6); PG8_BAR;
    }
    for (;;) {
        const bool has_next = S.next(ui + 1, nxt);
        const char* nA = has_next ? (const char*)g.A + (size_t)nxt.pm * tstepA + (size_t)nxt.pn * g.a_pn_off * 2 : cA; const char* nB = has_next ? (const char*)g.Bt + (size_t)nxt.pn * tstepB : cB;
        for (int t = 0; t < nt; t += 2) {
            const bool last = (t == nt - 2);
            const char* a1 = cA + (size_t)(t + 1) * kstep;
            const char* a2 = last ? nA : cA + (size_t)(t + 2) * kstep; const char* b2 = last ? nB : cB + (size_t)(t + 2) * kstep;
            const char* a3 = a2 + kstep; const char* b3 = b2 + kstep;
            if constexpr (Epi::MID) { if (t == 16 || t == 48) { if (wr == 0) PG8_BAR; E.mid(acc, cur, t, wr, wc, fr, fq); if (wr == 1) PG8_BAR; } }
            if constexpr (SP2) {
            PG8_LDB(B0, 0, 0); PG8_LDB(B1, 0, 1); PG8_SCHED; PG8_LDA(At, 0, 0); PG8_STAGE(PG8_SA(1, 1), a1 + hstepA, voffA);
            PG8_WAIT_V(8); PG8_WAIT_L(0); PG8_BAR; PG8_MMA(0, 0, At, B0); PG8_MMA(0, 1, At, B1); PG8_BAR; PG8_SCHED;
            PG8_LDA(At, 0, 1); PG8_STAGE(PG8_SB(0, 0), b2, voffB); PG8_STAGE(PG8_SB(0, 1), b2 + hstepB, voffB); PG8_STAGE(PG8_SA(0, 0), a2, voffA);
            PG8_WAIT_V(8); PG8_WAIT_L(0); PG8_BAR; PG8_MMA(1, 0, At, B0); PG8_MMA(1, 1, At, B1); PG8_BAR; PG8_SCHED;
            PG8_LDB(B0, 1, 0); PG8_LDB(B1, 1, 1); PG8_SCHED; PG8_LDA(At, 1, 0); PG8_STAGE(PG8_SA(0, 1), a2 + hstepA, voffA);
            PG8_WAIT_V(8); PG8_WAIT_L(0); PG8_BAR; PG8_MMA(0, 0, At, B0); PG8_MMA(0, 1, At, B1); PG8_BAR; PG8_SCHED;
            PG8_LDA(At, 1, 1); PG8_STAGE(PG8_SB(1, 0), b3, voffB); PG8_STAGE(PG8_SB(1, 1), b3 + hstepB, voffB); PG8_STAGE(PG8_SA(1, 0), a3, voffA);
            PG8_WAIT_V(8); PG8_WAIT_L(0); PG8_BAR; PG8_MMA(1, 0, At, B0); PG8_MMA(1, 1, At, B1); PG8_BAR; PG8_SCHED;
            } else {
            PG8_LDB(B0, 0, 0); PG8_SCHED; PG8_LDA(At, 0, 0); PG8_STAGE(PG8_SA(1, 1), a1 + hstepA, voffA);
            PG8_WAIT_L(8); PG8_BAR; PG8_WAIT_L(0); PG8_MMA(0, 0, At, B0); PG8_BAR; PG8_SCHED;
            PG8_LDB(B1, 0, 1); PG8_STAGE(PG8_SB(0, 0), b2, voffB);
            PG8_BAR; PG8_WAIT_L(0); PG8_MMA(0, 1, At, B1); PG8_BAR;
            PG8_LDA(At, 0, 1); PG8_STAGE(PG8_SA(0, 0), a2, voffA);
            PG8_BAR; PG8_WAIT_L(0); PG8_MMA(1, 0, At, B0); PG8_BAR; PG8_SCHED;
            PG8_STAGE(PG8_SB(0, 1), b2 + hstepB, voffB);
            PG8_WAIT_V(6); PG8_BAR; PG8_MMA(1, 1, At, B1); PG8_BAR;
            PG8_LDB(B0, 1, 0); PG8_SCHED; PG8_LDA(At, 1, 0); PG8_STAGE(PG8_SA(0, 1), a2 + hstepA, voffA);
            PG8_WAIT_L(8); PG8_BAR; PG8_WAIT_L(0); PG8_MMA(0, 0, At, B0); PG8_BAR; PG8_SCHED;
            PG8_LDB(B1, 1, 1); PG8_STAGE(PG8_SB(1, 0), b3, voffB);
            PG8_BAR; PG8_WAIT_L(0); PG8_MMA(0, 1, At, B1); PG8_BAR;
            PG8_LDA(At, 1, 1); PG8_STAGE(PG8_SA(1, 0), a3, voffA);
            PG8_BAR; PG8_WAIT_L(0); PG8_MMA(1, 0, At, B0); PG8_BAR; PG8_SCHED;
            PG8_STAGE(PG8_SB(1, 1), b3 + hstepB, voffB);
            PG8_WAIT_V(6); PG8_BAR; PG8_MMA(1, 1, At, B1); PG8_BAR;
            }
        }
        if constexpr (ALIGN_EPI) { if (wr == 0) PG8_BAR; }
        E(acc, cur, wr, wc, fr, fq);
        if (!has_next) break;
#pragma unroll
        for (int a = 0; a < 2; ++a)
#pragma unroll
            for (int b = 0; b < 2; ++b)
#pragma unroll
                for (int m = 0; m < 4; ++m)
#pragma unroll
                    for (int n = 0; n < 2; ++n) acc[a][b][m][n] = (f32x4){0.f, 0.f, 0.f, 0.f};
        cur = nxt; cA = nA; cB = nB; ++ui;
        if constexpr (ALIGN_EPI) { if (wr == 1) PG8_BAR; }
    }
    PG8_WAIT_V(0);
    if constexpr (!ALIGN_EPI) { if (wr == 0) PG8_BAR; }
    PG8_BAR;
#undef PG8_SA
#undef PG8_SB
#undef PG8_STAGE
#undef PG8_LDA
#undef PG8_LDB
#undef PG8_MMA
#undef PG8_WAIT_V
#undef PG8_WAIT_L
#undef PG8_BAR
#undef PG8_SCHED
}

typedef f32x4 AccT[2][2][4][2];

struct EpiInProj {
    static constexpr bool MID = false;
    bf16_t* proj; float* dt; const float* b_gate; bf16_t* gates; int pn_off; LAS const unsigned char* lbias;
    __device__ __forceinline__ void operator()(const AccT& acc, const Unit& u, int wr, int wc, int fr, int fq) const {
        fr = opq(fr); fq = opq(fq);
        const int row0 = u.pm * BM + wr * 64 + fr;
        const int upn = u.pn + pn_off;
        if (upn != 44) {
            const int col0 = upn * BM + wc * 32 + 8 * fq; const bool gate = upn >= 45, pgt = (upn >= 4) && (upn < 8), tl = gate || pgt;
            const int gk = gate ? (upn - 45) >> 3 : 3, gp = gate ? (upn - 45) & 7 : (upn & 3);
            const int tid = (wr * 4 + wc) * 64 + fq * 16 + fr;
            bf16_t* gbase = gates + ((size_t)((gk * 32 + u.pm) * 8 + gp) * 16 * 512 + tid) * 8;
            f32x4 bg[2][2];
#pragma unroll
            for (int bj = 0; bj < 2; ++bj)
#pragma unroll
                for (int n = 0; n < 2; ++n) { const u32x2 t = *(const LAS u32x2*)(lbias + ((gate ? (col0 + bj * HALF - 11520) : 0) + 4 * n) * 2); bg[bj][n] = (f32x4){bflo(t.x), bfhi(t.x), bflo(t.y), bfhi(t.y)}; }
#pragma unroll
            for (int ai = 0; ai < 2; ++ai)
#pragma unroll
                for (int m = 0; m < 4; ++m) { bf16_t* rowp = proj + (size_t)(row0 + ai * HALF + m * 16) * NPROJ + col0;
#pragma unroll
                    for (int bj = 0; bj < 2; ++bj) { f32x4 v0 = acc[ai][bj][m][0], v1 = acc[ai][bj][m][1];
#pragma unroll
                        for (int j = 0; j < 4; ++j) { const float s0 = sigmoidf_(v0[j] + bg[bj][0][j]), s1 = sigmoidf_(v1[j] + bg[bj][1][j]); v0[j] = gate ? s0 : v0[j]; v1[j] = gate ? s1 : v1[j]; }
                        u32x4 o; o.x = pk2(v0[0], v0[1]); o.y = pk2(v0[2], v0[3]); o.z = pk2(v1[0], v1[1]); o.w = pk2(v1[2], v1[3]);
                        bf16_t* dst = tl ? gbase + (size_t)(((ai * 4 + m) * 2 + bj) * 512) * 8 : rowp + bj * HALF;
                        *(u32x4*)dst = o; } }
        } else if (wc == 0) {
#pragma unroll
            for (int ai = 0; ai < 2; ++ai)
#pragma unroll
                for (int m = 0; m < 4; ++m) { float* rp = dt + (size_t)(row0 + ai * HALF + m * 16) * 32 + 8 * fq;
                    *(f32x4*)rp = acc[ai][0][m][0]; *(f32x4*)(rp + 4) = acc[ai][0][m][1]; }
        }
    }
};
struct EpiInProjU {
    static constexpr bool MID = false;
    bf16_t* proj; float* dt; bf16_t* gates; LAS const unsigned char* lbias; LAS const _Float16* lrstd;
    __device__ __forceinline__ void operator()(const AccT& acc, const Unit& u, int wr, int wc, int fr, int fq) const {
        fr = opq(fr); fq = opq(fq);
        const int row0 = u.pm * BM + wr * 64 + fr;
        const int tid = (wr * 4 + wc) * 64 + fq * 16 + fr;
        float rs[2][4];
#pragma unroll
        for (int ai = 0; ai < 2; ++ai)
#pragma unroll
            for (int m = 0; m < 4; ++m) rs[ai][m] = (float)lrstd[row0 + ai * HALF + m * 16];
        if (u.pn >= 45) {
            const int gpn = u.pn - 45, colb = gpn * BM + wc * 32 + 8 * fq;
            bf16_t* gbase = gates + ((size_t)(((gpn >> 3) * 32 + u.pm) * 8 + (gpn & 7)) * 16 * 512 + tid) * 8;
            f32x4 bg[2][2];
#pragma unroll
            for (int bj = 0; bj < 2; ++bj)
#pragma unroll
                for (int n = 0; n < 2; ++n) { const u32x2 t = *(const LAS u32x2*)(lbias + (colb + bj * HALF + 4 * n) * 2); bg[bj][n] = (f32x4){bflo(t.x), bfhi(t.x), bflo(t.y), bfhi(t.y)}; }
#pragma unroll
            for (int ai = 0; ai < 2; ++ai)
#pragma unroll
                for (int m = 0; m < 4; ++m)
#pragma unroll
                    for (int bj = 0; bj < 2; ++bj) { f32x4 v0 = acc[ai][bj][m][0], v1 = acc[ai][bj][m][1];
#pragma unroll
                        for (int j = 0; j < 4; ++j) { v0[j] = sigmoidf_(v0[j] * rs[ai][m] + bg[bj][0][j]); v1[j] = sigmoidf_(v1[j] * rs[ai][m] + bg[bj][1][j]); }
                        u32x4 o; o.x = pk2(v0[0], v0[1]); o.y = pk2(v0[2], v0[3]); o.z = pk2(v1[0], v1[1]); o.w = pk2(v1[2], v1[3]);
                        *(u32x4*)(gbase + (size_t)(((ai * 4 + m) * 2 + bj) * 512) * 8) = o; }
        } else if (u.pn < 44) {
            const int col0 = u.pn * BM + wc * 32 + 8 * fq; const bool tl = (u.pn >= 4) && (u.pn < 8);
            bf16_t* gbase = gates + ((size_t)((3 * 32 + u.pm) * 8 + (u.pn & 3)) * 16 * 512 + tid) * 8;
#pragma unroll
            for (int ai = 0; ai < 2; ++ai)
#pragma unroll
                for (int m = 0; m < 4; ++m) { bf16_t* rowp = proj + (size_t)(row0 + ai * HALF + m * 16) * NPROJ + col0;
#pragma unroll
                    for (int bj = 0; bj < 2; ++bj) { const f32x4 v0 = acc[ai][bj][m][0] * rs[ai][m], v1 = acc[ai][bj][m][1] * rs[ai][m];
                        u32x4 o; o.x = pk2(v0[0], v0[1]); o.y = pk2(v0[2], v0[3]); o.z = pk2(v1[0], v1[1]); o.w = pk2(v1[2], v1[3]);
                        bf16_t* dst = tl ? gbase + (size_t)(((ai * 4 + m) * 2 + bj) * 512) * 8 : rowp + bj * HALF;
                        *(u32x4*)dst = o; } }
        } else if (wc == 0) {
#pragma unroll
            for (int ai = 0; ai < 2; ++ai)
#pragma unroll
                for (int m = 0; m < 4; ++m) { float* rp = dt + (size_t)(row0 + ai * HALF + m * 16) * 32 + 8 * fq;
                    *(f32x4*)rp = acc[ai][0][m][0] * rs[ai][m]; *(f32x4*)(rp + 4) = acc[ai][0][m][1] * rs[ai][m]; }
        }
    }
};
struct EpiGrp {
    static constexpr bool MID = false;
    bf16_t* act; const bf16_t* gates; const float* scale;
    __device__ __forceinline__ void operator()(const AccT& acc, const Unit& u, int wr, int wc, int fr, int fq) const {
        fr = opq(fr); fq = opq(fq);
        const int row0 = u.pm * BM + wr * 64 + fr, col0 = u.pn * BM + wc * 32 + 8 * fq;
        const int tid = (wr * 4 + wc) * 64 + fq * 16 + fr;
        const bf16_t* pg = gates + ((size_t)((3 * 32 + u.pm) * 8 + u.pn) * 16 * 512 + tid) * 8;
        f32x4 sc[2][2];
#pragma unroll
        for (int bj = 0; bj < 2; ++bj)
#pragma unroll
            for (int n = 0; n < 2; ++n) sc[bj][n] = *(const f32x4*)(scale + col0 + bj * HALF + 4 * n);
#pragma unroll
        for (int ai = 0; ai < 2; ++ai)
#pragma unroll
            for (int m = 0; m < 4; ++m) { const size_t row = (size_t)(row0 + ai * HALF + m * 16); if ((m & 1) == 0) asm volatile("" ::: "memory");
#pragma unroll
                for (int bj = 0; bj < 2; ++bj) { const int col = col0 + bj * HALF;
                    float gf[8]; unpack8(*(const u32x4*)(pg + ((ai * 4 + m) * 2 + bj) * 512 * 8), gf);
                    float o[8];
#pragma unroll
                    for (int j = 0; j < 4; ++j) { o[j] = acc[ai][bj][m][0][j] * sc[bj][0][j] * siluf_(gf[j]); o[4 + j] = acc[ai][bj][m][1][j] * sc[bj][1][j] * siluf_(gf[4 + j]); }
                    *(u32x4*)(act + row * 4096 + col) = pack8(o); } }
    }
};
struct EpiBr {
    static constexpr bool MID = true;
    bf16_t* merged; const bf16_t* gates;
    __device__ __forceinline__ const bf16_t* gptr(const Unit& u, int k, int wr, int wc, int fr, int fq) const {
        const int tid = (wr * 4 + wc) * 64 + fq * 16 + fr;
        return gates + ((size_t)((k * 32 + u.pm) * 8 + u.pn) * 16 * 512 + tid) * 8;
    }
    __device__ __forceinline__ void mid(AccT& acc, const Unit& u, int t, int wr, int wc, int fr, int fq) const {
        fr = opq(fr); fq = opq(fq);
        const int ka = (t == 16) ? 0 : 1;
        const bf16_t* pa = gptr(u, ka, wr, wc, fr, fq); const bf16_t* pb = gptr(u, ka + 1, wr, wc, fr, fq);
#pragma unroll
        for (int ai = 0; ai < 2; ++ai)
#pragma unroll
            for (int m = 0; m < 4; ++m) { if (m == 0) asm volatile("" ::: "memory");
#pragma unroll
                for (int bj = 0; bj < 2; ++bj) { const int o = ((ai * 4 + m) * 2 + bj) * 512 * 8; float ga[8], gb[8]; unpack8(*(const u32x4*)(pa + o), ga); unpack8(*(const u32x4*)(pb + o), gb);
#pragma unroll
                    for (int j = 0; j < 4; ++j) { acc[ai][bj][m][0][j] *= ga[j] * __builtin_amdgcn_rcpf(fmaxf(gb[j], 1e-20f)); acc[ai][bj][m][1][j] *= ga[4 + j] * __builtin_amdgcn_rcpf(fmaxf(gb[4 + j], 1e-20f)); } } }
    }
    __device__ __forceinline__ void operator()(const AccT& acc, const Unit& u, int wr, int wc, int fr, int fq) const {
        fr = opq(fr); fq = opq(fq);
        const int row0 = u.pm * BM + wr * 64 + fr, col0 = u.pn * BM + wc * 32 + 8 * fq;
        const bf16_t* pg = gptr(u, 2, wr, wc, fr, fq);
#pragma unroll
        for (int ai = 0; ai < 2; ++ai)
#pragma unroll
            for (int m = 0; m < 4; ++m) { const size_t row = (size_t)(row0 + ai * HALF + m * 16); if (m == 0) asm volatile("" ::: "memory");
#pragma unroll
                for (int bj = 0; bj < 2; ++bj) { const int col = col0 + bj * HALF; float g2[8]; unpack8(*(const u32x4*)(pg + ((ai * 4 + m) * 2 + bj) * 512 * 8), g2);
                    float o[8];
#pragma unroll
                    for (int j = 0; j < 4; ++j) { o[j] = acc[ai][bj][m][0][j] * g2[j]; o[4 + j] = acc[ai][bj][m][1][j] * g2[4 + j]; }
                    *(u32x4*)(merged + row * DM + col) = pack8(o); } }
    }
};
struct EpiOut {
    static constexpr bool MID = false;
    const float* xin; float* xout; const float* nw_next; bf16_t* hout; float* rowsq;
    __device__ __forceinline__ void operator()(const AccT& acc, const Unit& u, int wr, int wc, int fr, int fq) const {
        fr = opq(fr); fq = opq(fq);
        const int row0 = u.pm * BM + wr * 64 + fr, col0 = u.pn * BM + wc * 32 + 8 * fq;
        const bool fuse = nw_next != nullptr;
        f32x4 nw[2][2];
#pragma unroll
        for (int bj = 0; bj < 2; ++bj)
#pragma unroll
            for (int n = 0; n < 2; ++n) nw[bj][n] = fuse ? *(const f32x4*)(nw_next + col0 + bj * HALF + 4 * n) : (f32x4){0.f, 0.f, 0.f, 0.f};
#pragma unroll
        for (int ai = 0; ai < 2; ++ai)
#pragma unroll
            for (int m = 0; m < 4; ++m) { const int row = row0 + ai * HALF + m * 16; const size_t off = (size_t)row * DM + col0; float ssq = 0.f;
                if ((m & 1) == 0) asm volatile("" ::: "memory");
#pragma unroll
                for (int bj = 0; bj < 2; ++bj) {
                    const f32x4 x0 = *(const f32x4*)(xin + off + bj * HALF), x1 = *(const f32x4*)(xin + off + bj * HALF + 4);
                    const f32x4 y0 = x0 + acc[ai][bj][m][0], y1 = x1 + acc[ai][bj][m][1];
                    *(f32x4*)(xout + off + bj * HALF) = y0; *(f32x4*)(xout + off + bj * HALF + 4) = y1;
                    if (fuse) {
                        ssq += (y0[0] * y0[0] + y0[1] * y0[1]) + (y0[2] * y0[2] + y0[3] * y0[3]) + (y1[0] * y1[0] + y1[1] * y1[1]) + (y1[2] * y1[2] + y1[3] * y1[3]);
                        const f32x4 h0 = y0 * nw[bj][0], h1 = y1 * nw[bj][1];
                        u32x4 o; o.x = pk2(h0[0], h0[1]); o.y = pk2(h0[2], h0[3]); o.z = pk2(h1[0], h1[1]); o.w = pk2(h1[2], h1[3]);
                        *(u32x4*)(hout + off + bj * HALF) = o; } }
                if (fuse) { ssq += __shfl_xor(ssq, 16); ssq += __shfl_xor(ssq, 32); if (fq == 0) atomicAdd(rowsq + row, ssq); } }
    }
};

__device__ __forceinline__ void cvt_matrix(const float* src, int K, int N, bf16_t* dst, int ld_dst, int dst_koff, int mode, LAS float* scr, int lane, int gw, int ngw) {
    const int nblk = N / 32, nitems = (K / 64) * nblk;
    for (int item = gw; item < nitems; item += ngw) {
        const int kb = item / nblk, nb = item - kb * nblk, k0 = 64 * kb, n0 = 32 * nb;
        const float* sp = src + (size_t)(k0 + (lane >> 5)) * N + n0 + (lane & 31);
        float v[32];
#pragma unroll
        for (int i = 0; i < 32; ++i) v[i] = __builtin_nontemporal_load(sp + (size_t)(2 * i) * N);
#pragma unroll
        for (int i = 0; i < 32; ++i) scr[(2 * i + (lane >> 5)) * 33 + (lane & 31)] = v[i];
        asm volatile("s_waitcnt lgkmcnt(0)" ::: "memory");
        int drow0 = n0;
        if (mode == 1) drow0 = n0 < 7168 ? n0 : (n0 < 7200 ? 11264 : (n0 < 11296 ? n0 - 32 : n0 + 224));
        const int c = lane & 7;
#pragma unroll
        for (int j = 0; j < 4; ++j) { const int n = (lane >> 3) + 8 * j; float f[8];
#pragma unroll
            for (int i = 0; i < 8; ++i) f[i] = scr[(8 * c + i) * 33 + n];
            *(u32x4*)(dst + (size_t)(drow0 + n) * ld_dst + dst_koff + k0 + 8 * c) = pack8(f); }
        asm volatile("s_waitcnt lgkmcnt(0)" ::: "memory");
    }
}
__device__ __forceinline__ void phase_convert(const Params& P, LAS unsigned char* lds) {
    const int tid_ = opq(threadIdx.x), lane = tid_ & 63, wave = tid_ >> 6;
    LAS float* scr = (LAS float*)(lds + wave * 8448);
    const int gw = blockIdx.x * 8 + wave, ngw = gridDim.x * 8;
#pragma unroll 1
    for (int L = 0; L < 4; ++L) {
        cvt_matrix(P.w_in + (size_t)L * DM * NIN_SRC, DM, NIN_SRC, P.bt_in() + (size_t)L * NIN_PAD * DM, DM, 0, 1, scr, lane, gw, ngw);
#pragma unroll 1
        for (int g = 0; g < 4; ++g) cvt_matrix(P.pool_w + ((size_t)L * 4 + g) * 65536, 256, 256, P.bt_grp() + ((size_t)L * 4 + g) * 65536, 256, 0, 0, scr, lane, gw, ngw);
        cvt_matrix(P.w_br_pool + (size_t)L * 1024 * DM, 1024, DM, P.bt_br() + (size_t)L * DM * 4096, 4096, 0, 0, scr, lane, gw, ngw);
        cvt_matrix(P.w_br_ssm + (size_t)L * 2048 * DM, 2048, DM, P.bt_br() + (size_t)L * DM * 4096, 4096, 1024, 0, scr, lane, gw, ngw);
        cvt_matrix(P.w_br_conv + (size_t)L * 1024 * DM, 1024, DM, P.bt_br() + (size_t)L * DM * 4096, 4096, 3072, 0, scr, lane, gw, ngw);
        cvt_matrix(P.w_out + (size_t)L * DM * DM, DM, DM, P.bt_out() + (size_t)L * DM * DM, DM, 0, 0, scr, lane, gw, ngw);
        u32x4* z = (u32x4*)(P.bt_in() + (size_t)L * NIN_PAD * DM + (size_t)11296 * DM);
        for (int i = blockIdx.x * 512 + tid_; i < 224 * 256; i += gridDim.x * 512) z[i] = (u32x4){0u, 0u, 0u, 0u};
    }
}

__device__ __forceinline__ void phase_rmsnorm(const float* xin, const float* w, bf16_t* hout, float* fout, float* rowsq_out = nullptr) {
    const int tid_ = opq(threadIdx.x); const int lane = tid_ & 63, wave = tid_ >> 6;
    for (int row = blockIdx.x * 8 + wave; row < M_TOK; row += gridDim.x * 8) {
        const f32x4* xr = (const f32x4*)(xin + (size_t)row * DM) + lane;
        f32x4 v[8]; float s = 0.f;
#pragma unroll
        for (int j = 0; j < 8; ++j) { v[j] = xr[64 * j]; s += (v[j][0] * v[j][0] + v[j][1] * v[j][1]) + (v[j][2] * v[j][2] + v[j][3] * v[j][3]); }
        s = wave_sum(s);
        const float rstd = rowsq_out ? 1.f : rsqrtf(s * (1.f / DM) + EPS);
        if (rowsq_out && lane == 0) rowsq_out[row] = s;
#pragma unroll
        for (int j = 0; j < 8; ++j) { const f32x4 wv = ((const f32x4*)w)[lane + 64 * j]; const f32x4 o = v[j] * rstd * wv;
            if (hout) { u32x2 pk; pk.x = pk2(o[0], o[1]); pk.y = pk2(o[2], o[3]); *(u32x2*)(hout + (size_t)row * DM + (lane + 64 * j) * 4) = pk; }
            else *(f32x4*)(fout + (size_t)row * DM + (lane + 64 * j) * 4) = o; }
    }
}

__device__ __forceinline__ void phase_prep(const Params& P, int L) {
    const int gtid = blockIdx.x * 512 + opq(threadIdx.x), gsz = gridDim.x * 512;
    const u32x4 zero4 = (u32x4){0u, 0u, 0u, 0u};
    for (int i = gtid; i < M_TOK; i += gsz) P.rowsq()[i] = 0.f;
    for (int it = gtid; it < 512 * 128; it += gsz) {
        const int ch8 = it & 127, blk = it >> 7, g = ch8 >> 5, win = 2 << g, t0 = blk * 16, pos0 = t0 & 4095;
        const bf16_t* up = P.proj() + (size_t)t0 * NPROJ + ch8 * 8;
        float s[8];
#pragma unroll
        for (int i = 0; i < 8; ++i) s[i] = 0.f;
        const int nh = (win - 1) < pos0 ? (win - 1) : pos0;
        for (int i = 1; i <= nh; ++i) { float f[8]; unpack8(*(const u32x4*)(up - (ptrdiff_t)i * NPROJ), f);
#pragma unroll
            for (int k = 0; k < 8; ++k) s[k] += f[k]; }
#pragma unroll 1
        for (int jb = 0; jb < 16; jb += 4) {
            u32x4 cu[4], ol[4];
#pragma unroll
            for (int r = 0; r < 4; ++r) cu[r] = *(const u32x4*)(up + (ptrdiff_t)(jb + r) * NPROJ);
#pragma unroll
            for (int r = 0; r < 4; ++r) { const int jo = jb + r - win + 1; ol[r] = zero4; if (pos0 + jo >= 0) ol[r] = *(const u32x4*)(up + (ptrdiff_t)jo * NPROJ); }
#pragma unroll
            for (int r = 0; r < 4; ++r) {
                float cur[8], o[8], d[8]; unpack8(cu[r], cur); unpack8(ol[r], o);
                const int pos = pos0 + jb + r; const int cnt = (pos + 1) < win ? (pos + 1) : win; const float inv = 1.f / (float)cnt;
#pragma unroll
                for (int k = 0; k < 8; ++k) { s[k] += cur[k]; d[k] = s[k] * inv - cur[k]; s[k] -= o[k]; }
                *(u32x4*)(P.dpool() + (size_t)(t0 + jb + r) * 1024 + ch8 * 8) = pack8(d);
            }
        }
    }
    for (int it = gtid; it < 512 * 384; it += gsz) {
        int ch8 = it % 384, blk = it / 384;
        if (gsz == 256 * 512) {
            const int w = gtid >> 9, xcd = w & 7, gq = xcd >> 1, bq = xcd & 1;
            const int j = (w >> 3) * 512 + (gtid & 511) + (it >= gsz ? 16384 : 0), bl = j / 96, cl = j - bl * 96;
            blk = bq * 256 + bl; ch8 = cl < 64 ? 64 * gq + cl : (cl < 80 ? 256 + 16 * gq + (cl - 64) : 320 + 16 * gq + (cl - 80)); }
        const int ch = ch8 * 8, t0 = blk * 16, pos0 = t0 & 4095;
        const float* cw = P.ssm_conv_w + (size_t)L * 4 * 3072 + ch; const float* cb = P.ssm_conv_b + (size_t)L * 3072 + ch;
        float w0[8], w1[8], w2[8], w3[8], bb[8];
#pragma unroll
        for (int k = 0; k < 8; ++k) { w0[k] = cw[k]; w1[k] = cw[3072 + k]; w2[k] = cw[2 * 3072 + k]; w3[k] = cw[3 * 3072 + k]; bb[k] = cb[k]; }
        const bf16_t* src = P.proj() + (size_t)t0 * NPROJ + 4096 + ch;
        float x1[8], x2[8], x3[8];
#pragma unroll
        for (int k = 0; k < 8; ++k) { x1[k] = 0.f; x2[k] = 0.f; x3[k] = 0.f; }
        if (pos0 >= 3) { unpack8(*(const u32x4*)(src - (ptrdiff_t)1 * NPROJ), x1); unpack8(*(const u32x4*)(src - (ptrdiff_t)2 * NPROJ), x2); unpack8(*(const u32x4*)(src - (ptrdiff_t)3 * NPROJ), x3); }
#pragma unroll 1
        for (int jb = 0; jb < 16; jb += 8) {
            u32x4 cu[8];
#pragma unroll
            for (int r = 0; r < 8; ++r) cu[r] = *(const u32x4*)(src + (ptrdiff_t)(jb + r) * NPROJ);
#pragma unroll
            for (int r = 0; r < 8; ++r) {
                float cur[8], o[8]; unpack8(cu[r], cur);
#pragma unroll
                for (int k = 0; k < 8; ++k) { const float a = bb[k] + w0[k] * x3[k] + w1[k] * x2[k] + w2[k] * x1[k] + w3[k] * cur[k]; o[k] = siluf_(a); x3[k] = x2[k]; x2[k] = x1[k]; x1[k] = cur[k]; }
                *(u32x4*)(P.xbc() + (size_t)(t0 + jb + r) * 3072 + ch) = pack8(o);
            }
        }
    }
    for (int it = gtid; it < 512 * 128; it += gsz) {
        const int ch8 = it & 127, blk = it >> 7, ch = ch8 * 8, t0 = blk * 16, pos0 = t0 & 4095;
        const float* cw = P.sc_conv_w + (size_t)L * 3 * 1024 + ch;
        float w0[8], w1[8], w2[8];
#pragma unroll
        for (int k = 0; k < 8; ++k) { w0[k] = cw[k]; w1[k] = cw[1024 + k]; w2[k] = cw[2048 + k]; }
        const bf16_t* base = P.proj() + (size_t)t0 * NPROJ + 7168 + ch;
        float m1[8], m2[8];
#pragma unroll
        for (int k = 0; k < 8; ++k) { m1[k] = 0.f; m2[k] = 0.f; }
        if (pos0 >= 2) { float a[8], b[8], c[8], d[8];
            unpack8(*(const u32x4*)(base - (ptrdiff_t)1 * NPROJ + 1024), a); unpack8(*(const u32x4*)(base - (ptrdiff_t)1 * NPROJ + 2048), b);
            unpack8(*(const u32x4*)(base - (ptrdiff_t)2 * NPROJ + 1024), c); unpack8(*(const u32x4*)(base - (ptrdiff_t)2 * NPROJ + 2048), d);
#pragma unroll
            for (int k = 0; k < 8; ++k) { m1[k] = a[k] * b[k]; m2[k] = c[k] * d[k]; } }
#pragma unroll 1
        for (int jb = 0; jb < 16; jb += 4) {
            u32x4 rb[4], rc[4], rv[4], rg[4];
#pragma unroll
            for (int r = 0; r < 4; ++r) { const bf16_t* rp = base + (ptrdiff_t)(jb + r) * NPROJ;
                rb[r] = *(const u32x4*)(rp); rc[r] = *(const u32x4*)(rp + 1024); rv[r] = *(const u32x4*)(rp + 2048); rg[r] = *(const u32x4*)(rp + 3072); }
#pragma unroll
            for (int r = 0; r < 4; ++r) {
                float vb[8], vc[8], vv[8], vg[8], o[8];
                unpack8(rb[r], vb); unpack8(rc[r], vc); unpack8(rv[r], vv); unpack8(rg[r], vg);
#pragma unroll
                for (int k = 0; k < 8; ++k) { const float mc = vc[k] * vv[k]; const float cv = w0[k] * m2[k] + w1[k] * m1[k] + w2[k] * mc; o[k] = vb[k] * cv * siluf_(vg[k]); m2[k] = m1[k]; m1[k] = mc; }
                *(u32x4*)(P.act() + (size_t)(t0 + jb + r) * 4096 + 3072 + ch) = pack8(o);
            }
        }
    }
}

__device__ __forceinline__ void ssd_dt_scan(const Params& P, int L, int m0, int g, int bc, LAS float* acum, LAS float* aux, int mode) {
    const int tid_ = opq(threadIdx.x); const int lane = tid_ & 63, e = tid_ >> 6, h = g * 8 + e;
    const float bias = P.ssm_dt_bias[L * 32 + h], a = -expf(P.ssm_a_log[L * 32 + h]);
    const float d0 = softplusf_(P.dt()[(size_t)(m0 + lane) * 32 + h] + bias), d1 = softplusf_(P.dt()[(size_t)(m0 + 64 + lane) * 32 + h] + bias);
    const float c0 = wave_scan_incl(d0 * a, lane); const float tot0 = __shfl(c0, 63);
    const float c1 = wave_scan_incl(d1 * a, lane) + tot0; const float alast = __shfl(c1, 63);
    acum[e * 128 + lane] = c0; acum[e * 128 + 64 + lane] = c1;
    if (mode == 0) { aux[e * 128 + lane] = d0 * __expf(alast - c0); aux[e * 128 + 64 + lane] = d1 * __expf(alast - c1);
        if (lane == 0) P.decay()[bc * 32 + h] = __expf(alast); }
    else { aux[e * 128 + lane] = d0; aux[e * 128 + 64 + lane] = d1; }
}

__device__ __forceinline__ void ssd_states_unit(const Params& P, int L, int unit, LAS unsigned char* lds) {
    const int tid = opq(threadIdx.x), lane = tid & 63, w = tid >> 6, fr = lane & 15, fq = lane >> 4, q = fr >> 2, pp = lane & 3;
    const int g = unit & 3, bc = unit >> 2, m0 = bc * 128;
    LAS unsigned char* Bm = lds;
    LAS unsigned char* XW = lds + 36864;
    LAS float* acum = (LAS float*)(lds + 102400); LAS float* wl = (LAS float*)(lds + 106496);
    ssd_dt_scan(P, L, m0, g, bc, acum, wl, 0);
#pragma unroll
    for (int it = 0; it < 4; ++it) { const int idx = it * 512 + tid, row = idx >> 4, c = idx & 15;
        *(LAS u32x4*)(Bm + row * 288 + c * 16) = *(const u32x4*)(P.xbc() + (size_t)(m0 + row) * 3072 + 2048 + g * 128 + c * 8); }
    __syncthreads();
#pragma unroll 1
    for (int pass = 0; pass < 2; ++pass) {
#pragma unroll
        for (int it = 0; it < 8; ++it) { const int idx = it * 512 + tid, row = idx >> 5, c = idx & 31, hh = c >> 3, p8 = (c & 7) * 8;
            float f[8]; unpack8(*(const u32x4*)(P.xbc() + (size_t)(m0 + row) * 3072 + g * 512 + (pass * 4 + hh) * 64 + p8), f);
            const float wv = wl[(pass * 4 + hh) * 128 + row];
#pragma unroll
            for (int k = 0; k < 8; ++k) f[k] *= wv;
            *(LAS u32x4*)(XW + hh * 16384 + row * 128 + p8 * 2) = pack8(f); }
        __syncthreads();
        const int hh = w & 3, ph = w >> 2;
        f32x4 acc[2][8];
#pragma unroll
        for (int a = 0; a < 2; ++a)
#pragma unroll
            for (int b = 0; b < 8; ++b) acc[a][b] = (f32x4){0.f, 0.f, 0.f, 0.f};
        const unsigned xbase = lds_addr(XW) + hh * 16384 + (8 * fq + q) * 128 + (ph * 32 + 4 * pp) * 2;
        const unsigned bbase = lds_addr(Bm) + (8 * fq + q) * 288 + (4 * pp) * 2;
#pragma unroll
        for (int ks = 0; ks < 4; ++ks) {
            bf16x8 xf0, xf1; tr_frag2<512, 32>(xbase + ks * 4096, xf0, xf1);
#pragma unroll
            for (int nh = 0; nh < 2; ++nh) { bf16x8 bf[4]; tr_frag4<1152, 32>(bbase + ks * 9216 + nh * 128, bf);
#pragma unroll
                for (int nn = 0; nn < 4; ++nn) { const int nt = nh * 4 + nn;
                    acc[0][nt] = __builtin_amdgcn_mfma_f32_16x16x32_bf16(bf[nn], xf0, acc[0][nt], 0, 0, 0);
                    acc[1][nt] = __builtin_amdgcn_mfma_f32_16x16x32_bf16(bf[nn], xf1, acc[1][nt], 0, 0, 0); } }
        }
        const int h = g * 8 + pass * 4 + hh; float* sp = P.states() + (size_t)(bc * 32 + h) * 8192;
#pragma unroll
        for (int pt = 0; pt < 2; ++pt)
#pragma unroll
            for (int nt = 0; nt < 8; ++nt) *(f32x4*)(sp + ((2 * ph + pt) * 16 + fr) * 128 + nt * 16 + 4 * fq) = acc[pt][nt];
        __syncthreads();
    }
}

__device__ __forceinline__ void phase_scan(const Params& P) {
    const int gtid = blockIdx.x * 512 + opq(threadIdx.x), gsz = gridDim.x * 512;
    for (int it0 = gtid; it0 < 2 * 32 * 2048; it0 += gsz) {
        int it = it0;
        if (gsz == 256 * 512) { const int w = it0 >> 9, t = it0 & 511, xcd = w & 7, k = w >> 3, idx = k * 512 + t; it = ((((xcd & 1) * 32) + (xcd >> 1) * 8 + (idx >> 11)) << 11) | (idx & 2047); }
        const int e4 = it & 2047, bh = it >> 11, b = bh >> 5, h = bh & 31;
        f32x4 carry = (f32x4){0.f, 0.f, 0.f, 0.f};
#pragma unroll 1
        for (int cb = 0; cb < 32; cb += 8) {
            f32x4 st[8]; float dec[8];
#pragma unroll
            for (int k = 0; k < 8; ++k) { const size_t idx = (size_t)((b * 32 + cb + k) * 32 + h); st[k] = *(const f32x4*)(P.states() + idx * 8192 + e4 * 4); dec[k] = P.decay()[idx]; }
            __builtin_amdgcn_sched_barrier(0);
#pragma unroll
            for (int k = 0; k < 8; ++k) { const size_t idx = (size_t)((b * 32 + cb + k) * 32 + h);
                u32x2 o; o.x = pk2(carry[0], carry[1]); o.y = pk2(carry[2], carry[3]);
                *(u32x2*)(P.prev() + idx * 8192 + e4 * 4) = o;
                carry = carry * dec[k] + st[k]; }
        }
    }
}

__device__ __forceinline__ void ssd_out_unit(const Params& P, int L, int unit, LAS unsigned char* lds) {
    const int tid = opq(threadIdx.x), lane = tid & 63, w = tid >> 6, fr0 = lane & 15, fq0 = lane >> 4;
    const int g = unit & 3, bc = unit >> 2, m0 = bc * 128;
    LAS unsigned char* Cm = lds; LAS unsigned char* Bm = lds + 34816;
    LAS unsigned char* X = lds;
    LAS float* acum = (LAS float*)(lds + 131072); LAS float* dts = (LAS float*)(lds + 135168); LAS float* red = (LAS float*)(lds + 139264);
    ssd_dt_scan(P, L, m0, g, bc, acum, dts, 1);
#pragma unroll
    for (int it = 0; it < 4; ++it) { const int idx = it * 512 + tid, row = idx >> 4, c = idx & 15;
        const bf16_t* rp = P.xbc() + (size_t)(m0 + row) * 3072 + 2048 + g * 128 + c * 8;
        *(LAS u32x4*)(Bm + row * 272 + c * 16) = *(const u32x4*)(rp); *(LAS u32x4*)(Cm + row * 272 + c * 16) = *(const u32x4*)(rp + 512); }
    __syncthreads();
    const int pair = w & 3, hq = w >> 2, lt0 = pair, lt1 = 7 - pair;
    f32x4 cb0[4], cb1[8];
#pragma unroll
    for (int i = 0; i < 4; ++i) cb0[i] = (f32x4){0.f, 0.f, 0.f, 0.f};
#pragma unroll
    for (int i = 0; i < 8; ++i) cb1[i] = (f32x4){0.f, 0.f, 0.f, 0.f};
    bf16x8 cfr[2][4];
    {
        const LAS unsigned char* cr0 = Cm + (lt0 * 16 + fr0) * 272 + fq0 * 16; const LAS unsigned char* cr1 = Cm + (lt1 * 16 + fr0) * 272 + fq0 * 16;
#pragma unroll
        for (int ks = 0; ks < 4; ++ks) { cfr[0][ks] = *(const LAS bf16x8*)(cr0 + ks * 64); cfr[1][ks] = *(const LAS bf16x8*)(cr1 + ks * 64); }
    }
    const LAS unsigned char* br = Bm + fr0 * 272 + fq0 * 16;
#pragma unroll
    for (int ks = 0; ks < 4; ++ks) {
#pragma unroll
        for (int S = 0; S < 8; ++S) { if (S <= lt1) { const bf16x8 bfr = *(const LAS bf16x8*)(br + S * 16 * 272 + ks * 64);
                cb1[S] = __builtin_amdgcn_mfma_f32_16x16x32_bf16(bfr, cfr[1][ks], cb1[S], 0, 0, 0);
                if (S < 4) { if (S <= lt0) cb0[S < 4 ? S : 0] = __builtin_amdgcn_mfma_f32_16x16x32_bf16(bfr, cfr[0][ks], cb0[S < 4 ? S : 0], 0, 0, 0); } } }
    }
    __syncthreads();
#pragma unroll
    for (int it = 0; it < 16; ++it) { const int idx = it * 512 + tid, row = idx >> 6, c = idx & 63, e = c >> 3, p8 = (c & 7) * 8;
        *(LAS u32x4*)(X + e * 16384 + row * 128 + p8 * 2) = *(const u32x4*)(P.xbc() + (size_t)(m0 + row) * 3072 + g * 512 + c * 8); }
    __syncthreads();
#pragma unroll
    for (int lo = 0; lo < 2; ++lo) {
        const int li = 1 - lo;
        const int lane_ = opq(lane), fr = lane_ & 15, fq = lane_ >> 4, q = fr >> 2, pp = lane_ & 3;
        const int lt = li ? lt1 : lt0, l = lt * 16 + fr; const size_t m = (size_t)(m0 + l);
        f32x4 acc[4][4];
#pragma unroll
        for (int i = 0; i < 4; ++i)
#pragma unroll
            for (int pt = 0; pt < 4; ++pt) acc[i][pt] = (f32x4){0.f, 0.f, 0.f, 0.f};
#pragma unroll
        for (int i = 0; i < 4; ++i) { const int e = hq * 4 + i, h = g * 8 + e; const bf16_t* pv = P.prev() + (size_t)(bc * 32 + h) * 8192;
            bf16x8 pf[16];
            asm volatile("" ::: "memory");
#pragma unroll
            for (int ks = 0; ks < 4; ++ks)
#pragma unroll
                for (int pt = 0; pt < 4; ++pt) pf[ks * 4 + pt] = *(const bf16x8*)(pv + (32 * (pt >> 1) + 8 * (fr >> 2) + 4 * (pt & 1) + (fr & 3)) * 128 + ks * 32 + fq * 8);
            __builtin_amdgcn_sched_barrier(0);
#pragma unroll
            for (int ks = 0; ks < 4; ++ks)
#pragma unroll
                for (int pt = 0; pt < 4; ++pt) acc[i][pt] = __builtin_amdgcn_mfma_f32_16x16x32_bf16(pf[ks * 4 + pt], cfr[li][ks], acc[i][pt], 0, 0, 0);
            const float sc = __expf(acum[e * 128 + l]);
#pragma unroll
            for (int pt = 0; pt < 4; ++pt) acc[i][pt] *= sc;
        }
#pragma unroll
        for (int i = 0; i < 4; ++i) { const int e = hq * 4 + i;
            const unsigned xb = lds_addr(X) + e * 16384 + (4 * fq + q) * 128 + (8 * pp) * 2;
            const float al = acum[e * 128 + l];
#pragma unroll
            for (int u = 0; u < (li ? 4 : 2); ++u) { if (2 * u <= lt) {
                    float gv[8];
#pragma unroll
                    for (int t = 0; t < 2; ++t) { const int S = 2 * u + t; const f32x4 cbt = li ? cb1[S] : cb0[S < 4 ? S : 0];
                        const f32x4 as = *(const LAS f32x4*)(acum + e * 128 + S * 16 + 4 * fq), ds = *(const LAS f32x4*)(dts + e * 128 + S * 16 + 4 * fq);
#pragma unroll
                        for (int j = 0; j < 4; ++j) { const int s = S * 16 + 4 * fq + j; const float v = cbt[j] * __expf(al - as[j]) * ds[j]; gv[4 * t + j] = (s <= l) ? v : 0.f; } }
                    const bf16x8 gf = __builtin_bit_cast(bf16x8, pack8(gv));
                    bf16x8 xf[4]; tr_frag4o<2048, 8, 64, 72>(xb + u * 4096, xf);
#pragma unroll
                    for (int pt = 0; pt < 4; ++pt) acc[i][pt] = __builtin_amdgcn_mfma_f32_16x16x32_bf16(xf[pt], gf, acc[i][pt], 0, 0, 0); } }
        }
        float ss = 0.f;
        u32x4 zz[8];
        asm volatile("" ::: "memory");
#pragma unroll
        for (int i = 0; i < 4; ++i)
#pragma unroll
            for (int k = 0; k < 2; ++k) zz[i * 2 + k] = *(const u32x4*)(P.proj() + m * NPROJ + 2048 + g * 512 + (hq * 4 + i) * 64 + 32 * k + 8 * fq);
        __builtin_amdgcn_sched_barrier(0);
#pragma unroll
        for (int i = 0; i < 4; ++i) { const int e = hq * 4 + i, h = g * 8 + e; const float Dk = P.ssm_d[L * 32 + h];
#pragma unroll
            for (int k = 0; k < 2; ++k) { const int p = 32 * k + 8 * fq;
                float xf_[8], zf[8]; unpack8(*(const LAS u32x4*)(X + e * 16384 + l * 128 + p * 2), xf_); unpack8(zz[i * 2 + k], zf);
#pragma unroll
                for (int j = 0; j < 4; ++j) { const float v0 = (acc[i][2 * k][j] + xf_[j] * Dk) * siluf_(zf[j]), v1 = (acc[i][2 * k + 1][j] + xf_[4 + j] * Dk) * siluf_(zf[4 + j]);
                    acc[i][2 * k][j] = v0; acc[i][2 * k + 1][j] = v1; ss += v0 * v0 + v1 * v1; } } }
        ss += __shfl_xor(ss, 16); ss += __shfl_xor(ss, 32);
        if (fq == 0) red[hq * 128 + l] = ss;
        __syncthreads();
        const float r = rsqrtf((red[l] + red[128 + l]) * (1.f / 512.f) + EPS);
#pragma unroll
        for (int i = 0; i < 4; ++i) { const int e = hq * 4 + i; if ((i & 1) == 0) asm volatile("" ::: "memory");
#pragma unroll
            for (int k = 0; k < 2; ++k) { const int ch = g * 512 + e * 64 + 32 * k + 8 * fq;
                const f32x4 nw0 = *(const f32x4*)(P.ssm_norm_w + (size_t)L * 2048 + ch), nw1 = *(const f32x4*)(P.ssm_norm_w + (size_t)L * 2048 + ch + 4);
                const f32x4 va = acc[i][2 * k], vb = acc[i][2 * k + 1];
                u32x4 o; o.x = pk2(va[0] * r * nw0[0], va[1] * r * nw0[1]); o.y = pk2(va[2] * r * nw0[2], va[3] * r * nw0[3]);
                o.z = pk2(vb[0] * r * nw1[0], vb[1] * r * nw1[1]); o.w = pk2(vb[2] * r * nw1[2], vb[3] * r * nw1[3]);
                *(u32x4*)(P.act() + m * 4096 + 1024 + ch) = o; } }
    }
    __syncthreads();
}


#define XB_TMO      128
#define XB_XCNT(j)  (256  + 64 * (j))
#define XB_XSUB(j)  (1280 + 64 * (j))
#define XB_XGEN(j)  (2304 + 64 * (j))
#define XB_TOP      3328
#define XB_TOPGEN   3392
#define XCD_BAR_WORDS 3456
#define XB_SPIN_CAP (1u << 18)
__device__ __forceinline__ unsigned xb_ld(unsigned* p)              { return __hip_atomic_load(p, __ATOMIC_RELAXED, __HIP_MEMORY_SCOPE_AGENT); }
__device__ __forceinline__ unsigned xb_add(unsigned* p, unsigned v) { return __hip_atomic_fetch_add(p, v, __ATOMIC_RELAXED, __HIP_MEMORY_SCOPE_AGENT); }
__device__ __forceinline__ unsigned xb_xcc_id() { return (unsigned)__builtin_amdgcn_s_getreg((3 << 11) | 20) & 0xFu; }
#define XB_SPIN(cond, bar) do { unsigned _sp = 0; while (cond) { __builtin_amdgcn_s_sleep(1); \
    if ((++_sp & 255u) == 0u) { if (xb_ld(&(bar)[XB_TMO])) break; if (_sp > XB_SPIN_CAP) { atomicAdd(&(bar)[XB_TMO], 1u); break; } } } } while (0)
struct XcdBarrier { unsigned* bar; unsigned x; volatile LAS unsigned* st; };
__device__ __forceinline__ XcdBarrier xcd_barrier_post(unsigned* bar, volatile LAS unsigned* st) {
    XcdBarrier b; b.bar = bar; b.x = xb_xcc_id(); b.st = st;
    if (threadIdx.x == 0) (void)xb_add(&bar[XB_XCNT(b.x)], 1u);
    return b;
}
__device__ __forceinline__ void xcd_barrier_complete(unsigned* bar, unsigned x, unsigned& nloc, unsigned& nx) {
    const unsigned G = gridDim.x * gridDim.y * gridDim.z;
    unsigned sum, cnt, mine, sp = 0u;
    for (;;) {
        sum = 0u; cnt = 0u; mine = 0u;
#pragma unroll
        for (unsigned j = 0; j < 16; ++j) { const unsigned c = xb_ld(&bar[XB_XCNT(j)]); sum += c; cnt += (c > 0u) ? 1u : 0u; mine = (j == x) ? c : mine; }
        if (sum == G) break;
        __builtin_amdgcn_s_sleep(1);
        if ((++sp & 255u) == 0u) { if (xb_ld(&bar[XB_TMO])) break; if (sp > XB_SPIN_CAP) { atomicAdd(&bar[XB_TMO], 1u); break; } }
    }
    nloc = mine > 0u ? mine : 1u; nx = cnt > 0u ? cnt : 1u;
}
__device__ __forceinline__ void xcd_barrier(const XcdBarrier& b) {
    asm volatile("s_waitcnt vmcnt(0)" ::: "memory");
    __syncthreads();
    if (threadIdx.x == 0) {
        unsigned* bar = b.bar;
        __builtin_amdgcn_s_waitcnt(0);
        unsigned nloc = b.st[0], nx = b.st[1];
        if (nloc == 0u) { xcd_barrier_complete(bar, b.x, nloc, nx); b.st[0] = nloc; b.st[1] = nx; }
        const unsigned old = xb_add(&bar[XB_XSUB(b.x)], 1u);
        const unsigned gen = old / nloc;
        if (old + 1u == (gen + 1u) * nloc) {
            __builtin_amdgcn_fence(__ATOMIC_RELEASE, "agent");
            asm volatile("s_waitcnt vmcnt(0)" ::: "memory");
            const unsigned og = xb_add(&bar[XB_TOP], 1u);
            const unsigned tg = og / nx;
            if (og + 1u == (tg + 1u) * nx) xb_add(&bar[XB_TOPGEN], 1u);
            else XB_SPIN(xb_ld(&bar[XB_TOPGEN]) == tg, bar);
            __builtin_amdgcn_fence(__ATOMIC_ACQUIRE, "agent");
            xb_add(&bar[XB_XGEN(b.x)], 1u);
            asm volatile("s_waitcnt vmcnt(0)" ::: "memory");
        } else {
            XB_SPIN(xb_ld(&bar[XB_XGEN(b.x)]) == gen, bar);
            __builtin_amdgcn_fence(__ATOMIC_ACQUIRE, "agent");
            asm volatile("s_waitcnt vmcnt(0)" ::: "memory");
        }
    }
    __syncthreads();
}

#ifndef REP_CVT
#define REP_CVT 1
#endif
#ifndef REP_NORM
#define REP_NORM 1
#endif
#ifndef REP_GIN
#define REP_GIN 1
#endif
#ifndef REP_PREP
#define REP_PREP 1
#endif
#ifndef REP_SSD
#define REP_SSD 1
#endif
#ifndef REP_GGRP
#define REP_GGRP 1
#endif
#ifndef REP_GBR
#define REP_GBR 1
#endif
#ifndef REP_GOUT
#define REP_GOUT 1
#endif
#ifndef REP_SYNC
#define REP_SYNC 1
#endif
#define GSYNC() do { for (int r_ = 0; r_ < REP_SYNC; ++r_) xcd_barrier(xb); } while (0)
__global__ void __launch_bounds__(512, 2) hybrid_fwd(Params P) {
    extern __shared__ __attribute__((aligned(16))) unsigned char shm_[];
    LAS unsigned char* lds = (LAS unsigned char*)shm_;
    cg::grid_group grid = cg::this_grid();
    const int G = (int)gridDim.x, c = (int)blockIdx.x;
    volatile LAS unsigned* xst = (volatile LAS unsigned*)(lds + LDS_BYTES - 16);
    if (threadIdx.x == 0) { xst[0] = 0u; xst[1] = 0u; xst[2] = 0u; xst[3] = 0u; }
    __syncthreads();
    const XcdBarrier xb = xcd_barrier_post(P.bar(), xst);
    for (int r = 0; r < REP_CVT; ++r) phase_convert(P, lds);
    phase_rmsnorm(P.x, P.norm_w, P.h(), nullptr, P.rowsq());
    grid.sync();
    GSYNC();
#pragma unroll 1
    for (int L = 0; L < 4; ++L) {
        const float* xin = L == 0 ? P.x : P.xcur();
        for (int r = 0; r < REP_GIN; ++r)
        { { const int t_ = opq(threadIdx.x); const float* bgp = P.b_gate + (size_t)L * 6144 + t_ * 12;
            const f32x4 b0 = *(const f32x4*)bgp, b1 = *(const f32x4*)(bgp + 4), b2 = *(const f32x4*)(bgp + 8);
            LAS u32x2* bl = (LAS u32x2*)(lds + 131072 + t_ * 24);
            u32x2 o0, o1, o2; o0.x = pk2(b0[0], b0[1]); o0.y = pk2(b0[2], b0[3]); o1.x = pk2(b1[0], b1[1]); o1.y = pk2(b1[2], b1[3]); o2.x = pk2(b2[0], b2[1]); o2.y = pk2(b2[2], b2[3]);
            bl[0] = o0; bl[1] = o1; bl[2] = o2;
            LAS _Float16* lr = (LAS _Float16*)(lds + 143360);
#pragma unroll
            for (int k = 0; k < 4; ++k) { const f32x4 q = *(const f32x4*)(P.rowsq() + t_ * 16 + k * 4);
#pragma unroll
                for (int j = 0; j < 4; ++j) lr[t_ * 16 + k * 4 + j] = (_Float16)rsqrtf(q[j] * (1.f / DM) + EPS); }
            __syncthreads(); }
          { Gemm g; g.A = P.h(); g.Bt = P.bt_in() + (size_t)L * NIN_PAD * DM; g.lda = DM; g.ldb = DM; g.K = DM; g.nM = 32; g.nN = 69; g.a_pn_off = 0;
            StaticOrder S; S.init(32, 69, G, c); EpiInProjU E; E.proj = P.proj(); E.dt = P.dt(); E.gates = P.gates(); E.lbias = lds + 131072; E.lrstd = (LAS const _Float16*)(lds + 143360);
            gemm_phase<EpiInProjU, true>(lds, g, S, E); } }
        GSYNC();
        for (int r = 0; r < REP_PREP; ++r) phase_prep(P, L);
        GSYNC();
        const bool split = (G == 256);
        for (int r = 0; r < REP_SSD; ++r) { if (split) { if (c < 128) { const int xcd = c & 7, k2 = c >> 3, ub = ((xcd & 1) * 32 + 2 * k2) * 4 + (xcd >> 1); ssd_states_unit(P, L, ub, lds); ssd_states_unit(P, L, ub + 4, lds); } } else for (int u = c; u < 256; u += G) ssd_states_unit(P, L, u, lds); }
        for (int r = 0; r < REP_GGRP; ++r)
        { Gemm g; g.A = P.dpool(); g.Bt = P.bt_grp() + (size_t)L * 1024 * 256; g.lda = 1024; g.ldb = 256; g.K = 256; g.nM = 32; g.nN = 4; g.a_pn_off = 256;
          StaticOrder S; if (split) S.init(32, 4, 128, c >= 128 ? c - 128 : 1 << 20); else S.init(32, 4, G, c); EpiGrp E; E.act = P.act(); E.gates = P.gates(); E.scale = P.pool_scale + (size_t)L * 1024;
          gemm_phase(lds, g, S, E); }
        GSYNC();
        for (int r = 0; r < REP_SSD; ++r) phase_scan(P);
        GSYNC();
        for (int r = 0; r < REP_SSD; ++r) { if (split) ssd_out_unit(P, L, ((c & 1) * 32 + (c >> 3)) * 4 + ((c & 7) >> 1), lds); else for (int u = c; u < 256; u += G) ssd_out_unit(P, L, u, lds); }
        GSYNC();
        for (int r = 0; r < REP_GBR; ++r)
        { Gemm g; g.A = P.act(); g.Bt = P.bt_br() + (size_t)L * DM * 4096; g.lda = 4096; g.ldb = 4096; g.K = 4096; g.nM = 32; g.nN = 8; g.a_pn_off = 0;
          StaticOrder S; S.init(32, 8, G, c); EpiBr E; E.merged = P.merged(); E.gates = P.gates();
          gemm_phase(lds, g, S, E); }
        GSYNC();
        for (int r = 0; r < REP_GOUT; ++r)
        { Gemm g; g.A = P.merged(); g.Bt = P.bt_out() + (size_t)L * DM * DM; g.lda = DM; g.ldb = DM; g.K = DM; g.nM = 32; g.nN = 8; g.a_pn_off = 0;
          StaticOrder S; S.init(32, 8, G, c); EpiOut E; E.xin = xin; E.xout = (r == REP_GOUT - 1) ? P.xcur() : P.states(); E.nw_next = (L < 3) ? P.norm_w + (size_t)(L + 1) * DM : nullptr; E.hout = P.h(); E.rowsq = P.rowsq();
          gemm_phase(lds, g, S, E); }
        GSYNC();
    }
    phase_rmsnorm(P.xcur(), P.final_norm_w, nullptr, P.out);
}

extern "C" void kernel_launch(void* const* d_in, const int* in_sizes, int n_in, void* d_out, int out_size, void* d_ws, size_t ws_size, hipStream_t stream) {
    static int grid_blocks = 0;
    if (!grid_blocks) {
        int dev = 0, cus = 0, per_cu = 0;
        hipGetDevice(&dev);
        hipDeviceGetAttribute(&cus, hipDeviceAttributeMultiprocessorCount, dev);
        if (hipFuncSetAttribute((const void*)hybrid_fwd, hipFuncAttributeMaxDynamicSharedMemorySize, LDS_BYTES) != hipSuccess) fprintf(stderr, "hipFuncSetAttribute failed\n");
        if (hipOccupancyMaxActiveBlocksPerMultiprocessor(&per_cu, (const void*)hybrid_fwd, 512, LDS_BYTES) != hipSuccess || per_cu < 1) { fprintf(stderr, "occupancy query gave %d\n", per_cu); per_cu = 1; }
        (void)hipGetLastError();
        grid_blocks = cus * per_cu;
        if (grid_blocks > 256) grid_blocks = 256;
    }
    Params p{};
    const float* const* in = (const float* const*)d_in;
    p.x = in[0]; p.norm_w = in[1]; p.w_in = in[2]; p.b_gate = in[3]; p.pool_w = in[4]; p.pool_scale = in[5]; p.ssm_conv_w = in[6]; p.ssm_conv_b = in[7];
    p.ssm_dt_bias = in[8]; p.ssm_a_log = in[9]; p.ssm_d = in[10]; p.ssm_norm_w = in[11]; p.sc_conv_w = in[12]; p.w_br_pool = in[13]; p.w_br_ssm = in[14];
    p.w_br_conv = in[15]; p.w_out = in[16]; p.final_norm_w = in[17];
    p.out = (float*)d_out;
    p.ws = (unsigned char*)d_ws;
    if (WS_END > ws_size) { fprintf(stderr, "workspace too small: need %zu have %zu\n", (size_t)WS_END, ws_size); return; }
    if (hipMemsetAsync((unsigned char*)d_ws + OFF_BAR, 0, 16384, stream) != hipSuccess) { fprintf(stderr, "memset of barrier words failed\n"); return; }
    void* args[] = {&p};
    hipError_t e = hipLaunchCooperativeKernel((const void*)hybrid_fwd, dim3(grid_blocks), dim3(512), args, LDS_BYTES, stream);
    if (e != hipSuccess) fprintf(stderr, "cooperative launch failed: %s (grid %d)\n", hipGetErrorString(e), grid_blocks);
}
```

```cpp
#include <hip/hip_runtime.h>
#include <hip/hip_cooperative_groups.h>
#include <cstdio>
#include <cstdint>
namespace cg = cooperative_groups;

#define LAS __attribute__((address_space(3)))
typedef unsigned short bf16_t;
typedef short bf16x8 __attribute__((ext_vector_type(8)));
typedef float f32x4 __attribute__((ext_vector_type(4)));
typedef unsigned u32x4 __attribute__((ext_vector_type(4)));
typedef unsigned u32x2 __attribute__((ext_vector_type(2)));

constexpr int M_TOK = 8192, DM = 2048, NPROJ = 17408, NIN_PAD = 17664, NIN_SRC = 17440;
constexpr int LDS_BYTES = 163840;
constexpr float EPS = 1e-6f;

constexpr size_t al256(size_t b) { return (b + 255) & ~(size_t)255; }
constexpr size_t OFF_BT_IN = 0;
constexpr size_t OFF_BT_GRP = OFF_BT_IN + al256((size_t)4 * NIN_PAD * DM * 2);
constexpr size_t OFF_BT_BR = OFF_BT_GRP + al256((size_t)4 * 1024 * 256 * 2);
constexpr size_t OFF_BT_OUT = OFF_BT_BR + al256((size_t)4 * DM * 4096 * 2);
constexpr size_t OFF_XCUR = OFF_BT_OUT + al256((size_t)4 * DM * DM * 2);
constexpr size_t OFF_H = OFF_XCUR + al256((size_t)M_TOK * DM * 4);
constexpr size_t OFF_PROJ = OFF_H + al256((size_t)M_TOK * DM * 2);
constexpr size_t OFF_DT = OFF_PROJ + al256((size_t)M_TOK * NPROJ * 2);
constexpr size_t OFF_DPOOL = OFF_DT + al256((size_t)M_TOK * 32 * 4);
constexpr size_t OFF_XBC = OFF_DPOOL + al256((size_t)M_TOK * 1024 * 2);
constexpr size_t OFF_ACT = OFF_XBC + al256((size_t)M_TOK * 3072 * 2);
constexpr size_t OFF_STATES = OFF_ACT + al256((size_t)M_TOK * 4096 * 2);
constexpr size_t OFF_PREV = OFF_STATES + al256((size_t)64 * 32 * 8192 * 4);
constexpr size_t OFF_DECAY = OFF_PREV + al256((size_t)64 * 32 * 8192 * 2);
constexpr size_t OFF_MERGED = OFF_DECAY + al256((size_t)64 * 32 * 4);
constexpr size_t OFF_GATES = OFF_MERGED + al256((size_t)M_TOK * DM * 2);
constexpr size_t OFF_BAR = OFF_GATES + al256((size_t)4 * M_TOK * DM * 2);
constexpr size_t OFF_ROWSQ = OFF_BAR + 16384;
constexpr size_t WS_END = OFF_ROWSQ + 32768;

struct Params {
    const float *x, *norm_w, *w_in, *b_gate, *pool_w, *pool_scale, *ssm_conv_w, *ssm_conv_b, *ssm_dt_bias, *ssm_a_log, *ssm_d,
        *ssm_norm_w, *sc_conv_w, *w_br_pool, *w_br_ssm, *w_br_conv, *w_out, *final_norm_w;
    float* out;
    unsigned char* ws;
    __device__ __forceinline__ bf16_t* bt_in() const { return (bf16_t*)(ws + OFF_BT_IN); }
    __device__ __forceinline__ bf16_t* bt_grp() const { return (bf16_t*)(ws + OFF_BT_GRP); }
    __device__ __forceinline__ bf16_t* bt_br() const { return (bf16_t*)(ws + OFF_BT_BR); }
    __device__ __forceinline__ bf16_t* bt_out() const { return (bf16_t*)(ws + OFF_BT_OUT); }
    __device__ __forceinline__ float* xcur() const { return (float*)(ws + OFF_XCUR); }
    __device__ __forceinline__ bf16_t* h() const { return (bf16_t*)(ws + OFF_H); }
    __device__ __forceinline__ bf16_t* proj() const { return (bf16_t*)(ws + OFF_PROJ); }
    __device__ __forceinline__ float* dt() const { return (float*)(ws + OFF_DT); }
    __device__ __forceinline__ bf16_t* dpool() const { return (bf16_t*)(ws + OFF_DPOOL); }
    __device__ __forceinline__ bf16_t* xbc() const { return (bf16_t*)(ws + OFF_XBC); }
    __device__ __forceinline__ bf16_t* act() const { return (bf16_t*)(ws + OFF_ACT); }
    __device__ __forceinline__ float* states() const { return (float*)(ws + OFF_STATES); }
    __device__ __forceinline__ bf16_t* prev() const { return (bf16_t*)(ws + OFF_PREV); }
    __device__ __forceinline__ float* decay() const { return (float*)(ws + OFF_DECAY); }
    __device__ __forceinline__ bf16_t* merged() const { return (bf16_t*)(ws + OFF_MERGED); }
    __device__ __forceinline__ bf16_t* gates() const { return (bf16_t*)(ws + OFF_GATES); }
    __device__ __forceinline__ unsigned* bar() const { return (unsigned*)(ws + OFF_BAR); }
    __device__ __forceinline__ float* rowsq() const { return (float*)(ws + OFF_ROWSQ); }
};

__device__ __forceinline__ unsigned pk2(float lo, float hi) { unsigned r; asm volatile("v_cvt_pk_bf16_f32 %0, %1, %2" : "=v"(r) : "v"(lo), "v"(hi)); return r; }
__device__ __forceinline__ float bflo(unsigned v) { return __uint_as_float(v << 16); }
__device__ __forceinline__ float bfhi(unsigned v) { return __uint_as_float(v & 0xffff0000u); }
__device__ __forceinline__ void unpack8(const u32x4 v, float (&f)[8]) {
    f[0] = bflo(v.x); f[1] = bfhi(v.x); f[2] = bflo(v.y); f[3] = bfhi(v.y); f[4] = bflo(v.z); f[5] = bfhi(v.z); f[6] = bflo(v.w); f[7] = bfhi(v.w);
}
__device__ __forceinline__ u32x4 pack8(const float (&f)[8]) { u32x4 o; o.x = pk2(f[0], f[1]); o.y = pk2(f[2], f[3]); o.z = pk2(f[4], f[5]); o.w = pk2(f[6], f[7]); return o; }
__device__ __forceinline__ float sigmoidf_(float v) { return __builtin_amdgcn_rcpf(1.f + __builtin_amdgcn_exp2f(-1.44269504f * v)); }
__device__ __forceinline__ float siluf_(float v) { return v * __builtin_amdgcn_rcpf(1.f + __builtin_amdgcn_exp2f(-1.44269504f * v)); }
__device__ __forceinline__ float softplusf_(float v) { return v > 20.f ? v : log1pf(expf(v)); }
__device__ __forceinline__ float wave_sum(float v) {
#pragma unroll
    for (int o = 1; o < 64; o <<= 1) v += __shfl_xor(v, o);
    return v;
}
__device__ __forceinline__ float wave_scan_incl(float v, int lane) {
#pragma unroll
    for (int o = 1; o < 64; o <<= 1) { const float t = __shfl_up(v, o); if (lane >= o) v += t; }
    return v;
}
__device__ __forceinline__ int opq(int v) { asm volatile("" : "+v"(v)); return v; }
__device__ __forceinline__ unsigned lds_addr(LAS const void* p) { return (unsigned)(uintptr_t)p; }
__device__ __forceinline__ bf16x8 mk_frag(u32x2 a, u32x2 b) { u32x4 r; r.x = a.x; r.y = a.y; r.z = b.x; r.w = b.y; return __builtin_bit_cast(bf16x8, r); }
template <int OFF2>
__device__ __forceinline__ bf16x8 tr_frag(unsigned addr) {
    u32x2 a, b;
    asm volatile("ds_read_b64_tr_b16 %0, %2\n\tds_read_b64_tr_b16 %1, %2 offset:%3\n\ts_waitcnt lgkmcnt(0)" : "=&v"(a), "=&v"(b) : "v"(addr), "n"(OFF2) : "memory");
    return mk_frag(a, b);
}
template <int OFF2, int STRIDE>
__device__ __forceinline__ void tr_frag2(unsigned addr, bf16x8& f0, bf16x8& f1) {
    u32x2 a0, b0, a1, b1;
    asm volatile("ds_read_b64_tr_b16 %0, %4\n\tds_read_b64_tr_b16 %1, %4 offset:%5\n\tds_read_b64_tr_b16 %2, %4 offset:%6\n\tds_read_b64_tr_b16 %3, %4 offset:%7\n\ts_waitcnt lgkmcnt(0)"
                 : "=&v"(a0), "=&v"(b0), "=&v"(a1), "=&v"(b1) : "v"(addr), "n"(OFF2), "n"(STRIDE), "n"(STRIDE + OFF2) : "memory");
    f0 = mk_frag(a0, b0); f1 = mk_frag(a1, b1);
}
template <int OFF2, int STRIDE>
__device__ __forceinline__ void tr_frag4(unsigned addr, bf16x8 (&f)[4]) {
    u32x2 a0, b0, a1, b1, a2, b2, a3, b3;
    asm volatile("ds_read_b64_tr_b16 %0, %8\n\tds_read_b64_tr_b16 %1, %8 offset:%9\n\tds_read_b64_tr_b16 %2, %8 offset:%10\n\tds_read_b64_tr_b16 %3, %8 offset:%11\n\t"
                 "ds_read_b64_tr_b16 %4, %8 offset:%12\n\tds_read_b64_tr_b16 %5, %8 offset:%13\n\tds_read_b64_tr_b16 %6, %8 offset:%14\n\tds_read_b64_tr_b16 %7, %8 offset:%15\n\ts_waitcnt lgkmcnt(0)"
                 : "=&v"(a0), "=&v"(b0), "=&v"(a1), "=&v"(b1), "=&v"(a2), "=&v"(b2), "=&v"(a3), "=&v"(b3)
                 : "v"(addr), "n"(OFF2), "n"(STRIDE), "n"(STRIDE + OFF2), "n"(2 * STRIDE), "n"(2 * STRIDE + OFF2), "n"(3 * STRIDE), "n"(3 * STRIDE + OFF2) : "memory");
    f[0] = mk_frag(a0, b0); f[1] = mk_frag(a1, b1); f[2] = mk_frag(a2, b2); f[3] = mk_frag(a3, b3);
}

template <int OFF2, int O1, int O2, int O3>
__device__ __forceinline__ void tr_frag4o(unsigned addr, bf16x8 (&f)[4]) {
    u32x2 a0, b0, a1, b1, a2, b2, a3, b3;
    asm volatile("ds_read_b64_tr_b16 %0, %8\n\tds_read_b64_tr_b16 %1, %8 offset:%9\n\tds_read_b64_tr_b16 %2, %8 offset:%10\n\tds_read_b64_tr_b16 %3, %8 offset:%11\n\t"
                 "ds_read_b64_tr_b16 %4, %8 offset:%12\n\tds_read_b64_tr_b16 %5, %8 offset:%13\n\tds_read_b64_tr_b16 %6, %8 offset:%14\n\tds_read_b64_tr_b16 %7, %8 offset:%15\n\ts_waitcnt lgkmcnt(0)"
                 : "=&v"(a0), "=&v"(b0), "=&v"(a1), "=&v"(b1), "=&v"(a2), "=&v"(b2), "=&v"(a3), "=&v"(b3)
                 : "v"(addr), "n"(OFF2), "n"(O1), "n"(O1 + OFF2), "n"(O2), "n"(O2 + OFF2), "n"(O3), "n"(O3 + OFF2) : "memory");
    f[0] = mk_frag(a0, b0); f[1] = mk_frag(a1, b1); f[2] = mk_frag(a2, b2); f[3] = mk_frag(a3, b3);
}

constexpr int BM = 256, BK = 64, HALF = 128, HTB = HALF * BK * 2, NXCD = 8, WGM = 8;
__device__ __forceinline__ int lds_byte(int r, int c) { const int st = (r >> 4) * 2 + (c >> 5), rr = r & 15, cc = c & 31, ob = rr * 64 + cc * 2; return st * 1024 + (ob ^ (((ob >> 9) & 1) << 5)); }
__device__ __forceinline__ void stage_rc(int b, int& R, int& C) { const int st = b / 1024, sb = b % 1024, swz = sb ^ (((sb >> 9) & 1) << 5); R = (st >> 1) * 16 + swz / 64; C = (st & 1) * 32 + (swz % 64) / 2; }
__device__ __forceinline__ int perm32(int rho) { const int n = rho >> 4, i = rho & 15; return 8 * (i >> 2) + 4 * n + (i & 3); }

struct Unit { int pm, pn; };
struct Gemm { const bf16_t* A; const bf16_t* Bt; int lda, ldb, K, nM, nN, a_pn_off; };
struct StaticOrder {
    int nM, nN, nwg, G, c;
    __device__ void init(int nM_, int nN_, int G_, int c_) { nM = nM_; nN = nN_; nwg = nM * nN; G = G_; c = c_; }
    __device__ bool next(int i, Unit& u) const {
        const long L = (long)i * G + c; if (L >= nwg) return false;
        int wgid = (int)L; { const int q = nwg / NXCD, r = nwg % NXCD, xcd = wgid % NXCD, off = wgid / NXCD; wgid = (xcd < r ? xcd * (q + 1) : r * (q + 1) + (xcd - r) * q) + off; }
        const int nig = WGM * nN, gid = wgid / nig, fm = gid * WGM, gsz = (nM - fm) < WGM ? (nM - fm) : WGM;
        u.pm = fm + ((wgid % nig) % gsz); u.pn = (wgid % nig) / gsz; return true;
    }
};

template <class Epi, bool ALIGN_EPI = false, bool SP2 = true>
__device__ __forceinline__ void gemm_phase(LAS unsigned char* lds, const Gemm g, const StaticOrder& S, const Epi& E) {
    const int tid = opq(threadIdx.x), wid = __builtin_amdgcn_readfirstlane(tid >> 6), lane = tid & 63, wr = wid >> 2, wc = wid & 3, fr = lane & 15, fq = lane >> 4;
    int K_ = g.K; asm volatile("" : "+s"(K_)); const int K = K_, nt = K / BK;
    unsigned voffA[2], voffB[2];
#pragma unroll
    for (int i = 0; i < 2; ++i) { int R, C; stage_rc(tid * 16 + i * 8192, R, C); const int Rb = (R & ~31) + perm32(R & 31);
        voffA[i] = (unsigned)(R * g.lda + C) * 2u; voffB[i] = (unsigned)(Rb * g.ldb + C) * 2u; }
    const size_t kstep = (size_t)(BK * 2);
    const size_t hstepA = (size_t)HALF * g.lda * 2, hstepB = (size_t)HALF * g.ldb * 2;
    const size_t tstepA = 2 * hstepA, tstepB = 2 * hstepB;
    const unsigned ldsw = (unsigned)wid * 1024u;
    const int aoff = lds_byte(wr * 64 + fr, fq * 8), boff = lds_byte(wc * 32 + fr, fq * 8);
#define PG8_SA(b, h) (((b) * 2 + (h)) * HTB)
#define PG8_SB(b, h) ((4 + (b) * 2 + (h)) * HTB)
#define PG8_STAGE(bufoff, gbase, voff) do { _Pragma("unroll") for (int _i = 0; _i < 2; ++_i) \
        __builtin_amdgcn_global_load_lds((const unsigned*)((const char*)(gbase) + (voff)[_i]), (LAS unsigned*)(lds + (bufoff) + ldsw + _i * 8192), 16, 0, 0); } while (0)
#define PG8_LDA(dst, b, h) do { _Pragma("unroll") for (int m = 0; m < 4; ++m) _Pragma("unroll") for (int k = 0; k < 2; ++k) dst[m][k] = *(const LAS bf16x8*)(lds + PG8_SA(b, h) + aoff + m * 2048 + k * 1024); } while (0)
#define PG8_LDB(dst, b, h) do { _Pragma("unroll") for (int n = 0; n < 2; ++n) _Pragma("unroll") for (int k = 0; k < 2; ++k) dst[n][k] = *(const LAS bf16x8*)(lds + PG8_SB(b, h) + boff + n * 2048 + k * 1024); } while (0)
#define PG8_MMA(ai, bj, At, Bt) do { __builtin_amdgcn_s_setprio(1); _Pragma("unroll") for (int m = 0; m < 4; ++m) _Pragma("unroll") for (int n = 0; n < 2; ++n) _Pragma("unroll") for (int k = 0; k < 2; ++k) \
        acc[ai][bj][m][n] = __builtin_amdgcn_mfma_f32_16x16x32_bf16(Bt[n][k], At[m][k], acc[ai][bj][m][n], 0, 0, 0); __builtin_amdgcn_s_setprio(0); } while (0)
#define PG8_WAIT_V(n) asm volatile("s_waitcnt vmcnt(" #n ")" ::: "memory")
#define PG8_WAIT_L(n) asm volatile("s_waitcnt lgkmcnt(" #n ")" ::: "memory")
#define PG8_BAR __builtin_amdgcn_s_barrier()
#define PG8_SCHED __builtin_amdgcn_sched_barrier(0)
    Unit cur, nxt; int ui = 0;
    if (!S.next(0, cur)) return;
    f32x4 acc[2][2][4][2];
#pragma unroll
    for (int a = 0; a < 2; ++a)
#pragma unroll
        for (int b = 0; b < 2; ++b)
#pragma unroll
            for (int m = 0; m < 4; ++m)
#pragma unroll
                for (int n = 0; n < 2; ++n) acc[a][b][m][n] = (f32x4){0.f, 0.f, 0.f, 0.f};
    bf16x8 At[4][2], B0[2][2], B1[2][2];
    const char* cA = (const char*)g.A + (size_t)cur.pm * tstepA + (size_t)cur.pn * g.a_pn_off * 2; const char* cB = (const char*)g.Bt + (size_t)cur.pn * tstepB;
    if constexpr (SP2) {
        PG8_STAGE(PG8_SB(0, 0), cB, voffB); PG8_STAGE(PG8_SB(0, 1), cB + hstepB, voffB); PG8_STAGE(PG8_SA(0, 0), cA, voffA); PG8_STAGE(PG8_SA(0, 1), cA + hstepA, voffA);
        if (wr == 1) PG8_BAR;
        PG8_WAIT_V(2); PG8_BAR;
        PG8_STAGE(PG8_SB(1, 0), cB + kstep, voffB); PG8_STAGE(PG8_SA(1, 0), cA + kstep, voffA); PG8_STAGE(PG8_SB(1, 1), cB + hstepB + kstep, voffB);
        PG8_WAIT_V(6); PG8_BAR;
    } else {
    PG8_STAGE(PG8_SB(0, 0), cB, voffB); PG8_STAGE(PG8_SA(0, 0), cA, voffA); PG8_STAGE(PG8_SB(0, 1), cB + hstepB, voffB); PG8_STAGE(PG8_SA(0, 1), cA + hstepA, voffA);
    if (wr == 1) PG8_BAR;
    PG8_WAIT_V(4); PG8_BAR;
    PG8_STAGE(PG8_SB(1, 0), cB + kstep, voffB); PG8_STAGE(PG8_SA(1, 0), cA + kstep, voffA); PG8_STAGE(PG8_SB(1, 1), cB + hstepB + kstep, voffB);
    PG8_WAIT_V(6); PG8_BAR;
    }
    for (;;) {
        const bool has_next = S.next(ui + 1, nxt);
        const char* nA = has_next ? (const char*)g.A + (size_t)nxt.pm * tstepA + (size_t)nxt.pn * g.a_pn_off * 2 : cA; const char* nB = has_next ? (const char*)g.Bt + (size_t)nxt.pn * tstepB : cB;
        for (int t = 0; t < nt; t += 2) {
            const bool last = (t == nt - 2);
            const char* a1 = cA + (size_t)(t + 1) * kstep;
            const char* a2 = last ? nA : cA + (size_t)(t + 2) * kstep; const char* b2 = last ? nB : cB + (size_t)(t + 2) * kstep;
            const char* a3 = a2 + kstep; const char* b3 = b2 + kstep;
            if constexpr (Epi::MID) { if (t == 16 || t == 48) { if (wr == 0) PG8_BAR; E.mid(acc, cur, t, wr, wc, fr, fq); if (wr == 1) PG8_BAR; } }
            if constexpr (SP2) {
            PG8_LDB(B0, 0, 0); PG8_LDB(B1, 0, 1); PG8_SCHED; PG8_LDA(At, 0, 0); PG8_STAGE(PG8_SA(1, 1), a1 + hstepA, voffA);
            PG8_WAIT_V(8); PG8_WAIT_L(0); PG8_BAR; PG8_MMA(0, 0, At, B0); PG8_MMA(0, 1, At, B1); PG8_BAR; PG8_SCHED;
            PG8_LDA(At, 0, 1); PG8_STAGE(PG8_SB(0, 0), b2, voffB); PG8_STAGE(PG8_SB(0, 1), b2 + hstepB, voffB); PG8_STAGE(PG8_SA(0, 0), a2, voffA);
            PG8_WAIT_V(8); PG8_WAIT_L(0); PG8_BAR; PG8_MMA(1, 0, At, B0); PG8_MMA(1, 1, At, B1); PG8_BAR; PG8_SCHED;
            PG8_LDB(B0, 1, 0); PG8_LDB(B1, 1, 1); PG8_SCHED; PG8_LDA(At, 1, 0); PG8_STAGE(PG8_SA(0, 1), a2 + hstepA, voffA);
            PG8_WAIT_V(8); PG8_WAIT_L(0); PG8_BAR; PG8_MMA(0, 0, At, B0); PG8_MMA(0, 1, At, B1); PG8_BAR; PG8_SCHED;
            PG8_LDA(At, 1, 1); PG8_STAGE(PG8_SB(1, 0), b3, voffB); PG8_STAGE(PG8_SB(1, 1), b3 + hstepB, voffB); PG8_STAGE(PG8_SA(1, 0), a3, voffA);
            PG8_WAIT_V(8); PG8_WAIT_L(0); PG8_BAR; PG8_MMA(1, 0, At, B0); PG8_MMA(1, 1, At, B1); PG8_BAR; PG8_SCHED;
            } else {
            PG8_LDB(B0, 0, 0); PG8_SCHED; PG8_LDA(At, 0, 0); PG8_STAGE(PG8_SA(1, 1), a1 + hstepA, voffA);
            PG8_WAIT_L(8); PG8_BAR; PG8_WAIT_L(0); PG8_MMA(0, 0, At, B0); PG8_BAR; PG8_SCHED;
            PG8_LDB(B1, 0, 1); PG8_STAGE(PG8_SB(0, 0), b2, voffB);
            PG8_BAR; PG8_WAIT_L(0); PG8_MMA(0, 1, At, B1); PG8_BAR;
            PG8_LDA(At, 0, 1); PG8_STAGE(PG8_SA(0, 0), a2, voffA);
            PG8_BAR; PG8_WAIT_L(0); PG8_MMA(1, 0, At, B0); PG8_BAR; PG8_SCHED;
            PG8_STAGE(PG8_SB(0, 1), b2 + hstepB, voffB);
            PG8_WAIT_V(6); PG8_BAR; PG8_MMA(1, 1, At, B1); PG8_BAR;
            PG8_LDB(B0, 1, 0); PG8_SCHED; PG8_LDA(At, 1, 0); PG8_STAGE(PG8_SA(0, 1), a2 + hstepA, voffA);
            PG8_WAIT_L(8); PG8_BAR; PG8_WAIT_L(0); PG8_MMA(0, 0, At, B0); PG8_BAR; PG8_SCHED;
            PG8_LDB(B1, 1, 1); PG8_STAGE(PG8_SB(1, 0), b3, voffB);
            PG8_BAR; PG8_WAIT_L(0); PG8_MMA(0, 1, At, B1); PG8_BAR;
            PG8_LDA(At, 1, 1); PG8_STAGE(PG8_SA(1, 0), a3, voffA);
            PG8_BAR; PG8_WAIT_L(0); PG8_MMA(1, 0, At, B0); PG8_BAR; PG8_SCHED;
            PG8_STAGE(PG8_SB(1, 1), b3 + hstepB, voffB);
            PG8_WAIT_V(6); PG8_BAR; PG8_MMA(1, 1, At, B1); PG8_BAR;
            }
        }
        if constexpr (ALIGN_EPI) { if (wr == 0) PG8_BAR; }
        E(acc, cur, wr, wc, fr, fq);
        if (!has_next) break;
#pragma unroll
        for (int a = 0; a < 2; ++a)
#pragma unroll
            for (int b = 0; b < 2; ++b)
#pragma unroll
                for (int m = 0; m < 4; ++m)
#pragma unroll
                    for (int n = 0; n < 2; ++n) acc[a][b][m][n] = (f32x4){0.f, 0.f, 0.f, 0.f};
        cur = nxt; cA = nA; cB = nB; ++ui;
        if constexpr (ALIGN_EPI) { if (wr == 1) PG8_BAR; }
    }
    PG8_WAIT_V(0);
    if constexpr (!ALIGN_EPI) { if (wr == 0) PG8_BAR; }
    PG8_BAR;
#undef PG8_SA
#undef PG8_SB
#undef PG8_STAGE
#undef PG8_LDA
#undef PG8_LDB
#undef PG8_MMA
#undef PG8_WAIT_V
#undef PG8_WAIT_L
#undef PG8_BAR
#undef PG8_SCHED
}

typedef f32x4 AccT[2][2][4][2];

struct EpiInProj {
    static constexpr bool MID = false;
    bf16_t* proj; float* dt; const float* b_gate; bf16_t* gates; int pn_off; LAS const unsigned char* lbias;
    __device__ __forceinline__ void operator()(const AccT& acc, const Unit& u, int wr, int wc, int fr, int fq) const {
        fr = opq(fr); fq = opq(fq);
        const int row0 = u.pm * BM + wr * 64 + fr;
        const int upn = u.pn + pn_off;
        if (upn != 44) {
            const int col0 = upn * BM + wc * 32 + 8 * fq; const bool gate = upn >= 45, pgt = (upn >= 4) && (upn < 8), tl = gate || pgt;
            const int gk = gate ? (upn - 45) >> 3 : 3, gp = gate ? (upn - 45) & 7 : (upn & 3);
            const int tid = (wr * 4 + wc) * 64 + fq * 16 + fr;
            bf16_t* gbase = gates + ((size_t)((gk * 32 + u.pm) * 8 + gp) * 16 * 512 + tid) * 8;
            f32x4 bg[2][2];
#pragma unroll
            for (int bj = 0; bj < 2; ++bj)
#pragma unroll
                for (int n = 0; n < 2; ++n) { const u32x2 t = *(const LAS u32x2*)(lbias + ((gate ? (col0 + bj * HALF - 11520) : 0) + 4 * n) * 2); bg[bj][n] = (f32x4){bflo(t.x), bfhi(t.x), bflo(t.y), bfhi(t.y)}; }
#pragma unroll
            for (int ai = 0; ai < 2; ++ai)
#pragma unroll
                for (int m = 0; m < 4; ++m) { bf16_t* rowp = proj + (size_t)(row0 + ai * HALF + m * 16) * NPROJ + col0;
#pragma unroll
                    for (int bj = 0; bj < 2; ++bj) { f32x4 v0 = acc[ai][bj][m][0], v1 = acc[ai][bj][m][1];
#pragma unroll
                        for (int j = 0; j < 4; ++j) { const float s0 = sigmoidf_(v0[j] + bg[bj][0][j]), s1 = sigmoidf_(v1[j] + bg[bj][1][j]); v0[j] = gate ? s0 : v0[j]; v1[j] = gate ? s1 : v1[j]; }
                        u32x4 o; o.x = pk2(v0[0], v0[1]); o.y = pk2(v0[2], v0[3]); o.z = pk2(v1[0], v1[1]); o.w = pk2(v1[2], v1[3]);
                        bf16_t* dst = tl ? gbase + (size_t)(((ai * 4 + m) * 2 + bj) * 512) * 8 : rowp + bj * HALF;
                        *(u32x4*)dst = o; } }
        } else if (wc == 0) {
#pragma unroll
            for (int ai = 0; ai < 2; ++ai)
#pragma unroll
                for (int m = 0; m < 4; ++m) { float* rp = dt + (size_t)(row0 + ai * HALF + m * 16) * 32 + 8 * fq;
                    *(f32x4*)rp = acc[ai][0][m][0]; *(f32x4*)(rp + 4) = acc[ai][0][m][1]; }
        }
    }
};
struct EpiInProjU {
    static constexpr bool MID = false;
    bf16_t* proj; float* dt; bf16_t* gates; LAS const unsigned char* lbias; LAS const _Float16* lrstd;
    __device__ __forceinline__ void operator()(const AccT& acc, const Unit& u, int wr, int wc, int fr, int fq) const {
        fr = opq(fr); fq = opq(fq);
        const int row0 = u.pm * BM + wr * 64 + fr;
        const int tid = (wr * 4 + wc) * 64 + fq * 16 + fr;
        float rs[2][4];
#pragma unroll
        for (int ai = 0; ai < 2; ++ai)
#pragma unroll
            for (int m = 0; m < 4; ++m) rs[ai][m] = (float)lrstd[row0 + ai * HALF + m * 16];
        if (u.pn >= 45) {
            const int gpn = u.pn - 45, colb = gpn * BM + wc * 32 + 8 * fq;
            bf16_t* gbase = gates + ((size_t)(((gpn >> 3) * 32 + u.pm) * 8 + (gpn & 7)) * 16 * 512 + tid) * 8;
            f32x4 bg[2][2];
#pragma unroll
            for (int bj = 0; bj < 2; ++bj)
#pragma unroll
                for (int n = 0; n < 2; ++n) { const u32x2 t = *(const LAS u32x2*)(lbias + (colb + bj * HALF + 4 * n) * 2); bg[bj][n] = (f32x4){bflo(t.x), bfhi(t.x), bflo(t.y), bfhi(t.y)}; }
#pragma unroll
            for (int ai = 0; ai < 2; ++ai)
#pragma unroll
                for (int m = 0; m < 4; ++m)
#pragma unroll
                    for (int bj = 0; bj < 2; ++bj) { f32x4 v0 = acc[ai][bj][m][0], v1 = acc[ai][bj][m][1];
#pragma unroll
                        for (int j = 0; j < 4; ++j) { v0[j] = sigmoidf_(v0[j] * rs[ai][m] + bg[bj][0][j]); v1[j] = sigmoidf_(v1[j] * rs[ai][m] + bg[bj][1][j]); }
                        u32x4 o; o.x = pk2(v0[0], v0[1]); o.y = pk2(v0[2], v0[3]); o.z = pk2(v1[0], v1[1]); o.w = pk2(v1[2], v1[3]);
                        *(u32x4*)(gbase + (size_t)(((ai * 4 + m) * 2 + bj) * 512) * 8) = o; }
        } else if (u.pn < 44) {
            const int col0 = u.pn * BM + wc * 32 + 8 * fq; const bool tl = (u.pn >= 4) && (u.pn < 8);
            bf16_t* gbase = gates + ((size_t)((3 * 32 + u.pm) * 8 + (u.pn & 3)) * 16 * 512 + tid) * 8;
#pragma unroll
            for (int ai = 0; ai < 2; ++ai)
#pragma unroll
                for (int m = 0; m < 4; ++m) { bf16_t* rowp = proj + (size_t)(row0 + ai * HALF + m * 16) * NPROJ + col0;
#pragma unroll
                    for (int bj = 0; bj < 2; ++bj) { const f32x4 v0 = acc[ai][bj][m][0] * rs[ai][m], v1 = acc[ai][bj][m][1] * rs[ai][m];
                        u32x4 o; o.x = pk2(v0[0], v0[1]); o.y = pk2(v0[2], v0[3]); o.z = pk2(v1[0], v1[1]); o.w = pk2(v1[2], v1[3]);
                        bf16_t* dst = tl ? gbase + (size_t)(((ai * 4 + m) * 2 + bj) * 512) * 8 : rowp + bj * HALF;
                        *(u32x4*)dst = o; } }
        } else if (wc == 0) {
#pragma unroll
            for (int ai = 0; ai < 2; ++ai)
#pragma unroll
                for (int m = 0; m < 4; ++m) { float* rp = dt + (size_t)(row0 + ai * HALF + m * 16) * 32 + 8 * fq;
                    *(f32x4*)rp = acc[ai][0][m][0] * rs[ai][m]; *(f32x4*)(rp + 4) = acc[ai][0][m][1] * rs[ai][m]; }
        }
    }
};
struct EpiGrp {
    static constexpr bool MID = false;
    bf16_t* act; const bf16_t* gates; const float* scale;
    __device__ __forceinline__ void operator()(const AccT& acc, const Unit& u, int wr, int wc, int fr, int fq) const {
        fr = opq(fr); fq = opq(fq);
        const int row0 = u.pm * BM + wr * 64 + fr, col0 = u.pn * BM + wc * 32 + 8 * fq;
        const int tid = (wr * 4 + wc) * 64 + fq * 16 + fr;
        const bf16_t* pg = gates + ((size_t)((3 * 32 + u.pm) * 8 + u.pn) * 16 * 512 + tid) * 8;
        f32x4 sc[2][2];
#pragma unroll
        for (int bj = 0; bj < 2; ++bj)
#pragma unroll
            for (int n = 0; n < 2; ++n) sc[bj][n] = *(const f32x4*)(scale + col0 + bj * HALF + 4 * n);
#pragma unroll
        for (int ai = 0; ai < 2; ++ai)
#pragma unroll
            for (int m = 0; m < 4; ++m) { const size_t row = (size_t)(row0 + ai * HALF + m * 16); if ((m & 1) == 0) asm volatile("" ::: "memory");
#pragma unroll
                for (int bj = 0; bj < 2; ++bj) { const int col = col0 + bj * HALF;
                    float gf[8]; unpack8(*(const u32x4*)(pg + ((ai * 4 + m) * 2 + bj) * 512 * 8), gf);
                    float o[8];
#pragma unroll
                    for (int j = 0; j < 4; ++j) { o[j] = acc[ai][bj][m][0][j] * sc[bj][0][j] * siluf_(gf[j]); o[4 + j] = acc[ai][bj][m][1][j] * sc[bj][1][j] * siluf_(gf[4 + j]); }
                    *(u32x4*)(act + row * 4096 + col) = pack8(o); } }
    }
};
struct EpiBr {
    static constexpr bool MID = true;
    bf16_t* merged; const bf16_t* gates;
    __device__ __forceinline__ const bf16_t* gptr(const Unit& u, int k, int wr, int wc, int fr, int fq) const {
        const int tid = (wr * 4 + wc) * 64 + fq * 16 + fr;
        return gates + ((size_t)((k * 32 + u.pm) * 8 + u.pn) * 16 * 512 + tid) * 8;
    }
    __device__ __forceinline__ void mid(AccT& acc, const Unit& u, int t, int wr, int wc, int fr, int fq) const {
        fr = opq(fr); fq = opq(fq);
        const int ka = (t == 16) ? 0 : 1;
        const bf16_t* pa = gptr(u, ka, wr, wc, fr, fq); const bf16_t* pb = gptr(u, ka + 1, wr, wc, fr, fq);
#pragma unroll
        for (int ai = 0; ai < 2; ++ai)
#pragma unroll
            for (int m = 0; m < 4; ++m) { if (m == 0) asm volatile("" ::: "memory");
#pragma unroll
                for (int bj = 0; bj < 2; ++bj) { const int o = ((ai * 4 + m) * 2 + bj) * 512 * 8; float ga[8], gb[8]; unpack8(*(const u32x4*)(pa + o), ga); unpack8(*(const u32x4*)(pb + o), gb);
#pragma unroll
                    for (int j = 0; j < 4; ++j) { acc[ai][bj][m][0][j] *= ga[j] * __builtin_amdgcn_rcpf(fmaxf(gb[j], 1e-20f)); acc[ai][bj][m][1][j] *= ga[4 + j] * __builtin_amdgcn_rcpf(fmaxf(gb[4 + j], 1e-20f)); } } }
    }
    __device__ __forceinline__ void operator()(const AccT& acc, const Unit& u, int wr, int wc, int fr, int fq) const {
        fr = opq(fr); fq = opq(fq);
        const int row0 = u.pm * BM + wr * 64 + fr, col0 = u.pn * BM + wc * 32 + 8 * fq;
        const bf16_t* pg = gptr(u, 2, wr, wc, fr, fq);
#pragma unroll
        for (int ai = 0; ai < 2; ++ai)
#pragma unroll
            for (int m = 0; m < 4; ++m) { const size_t row = (size_t)(row0 + ai * HALF + m * 16); if (m == 0) asm volatile("" ::: "memory");
#pragma unroll
                for (int bj = 0; bj < 2; ++bj) { const int col = col0 + bj * HALF; float g2[8]; unpack8(*(const u32x4*)(pg + ((ai * 4 + m) * 2 + bj) * 512 * 8), g2);
                    float o[8];
#pragma unroll
                    for (int j = 0; j < 4; ++j) { o[j] = acc[ai][bj][m][0][j] * g2[j]; o[4 + j] = acc[ai][bj][m][1][j] * g2[4 + j]; }
                    *(u32x4*)(merged + row * DM + col) = pack8(o); } }
    }
};
struct EpiOut {
    static constexpr bool MID = false;
    const float* xin; float* xout; const float* nw_next; bf16_t* hout; float* rowsq;
    __device__ __forceinline__ void operator()(const AccT& acc, const Unit& u, int wr, int wc, int fr, int fq) const {
        fr = opq(fr); fq = opq(fq);
        const int row0 = u.pm * BM + wr * 64 + fr, col0 = u.pn * BM + wc * 32 + 8 * fq;
        const bool fuse = nw_next != nullptr;
        f32x4 nw[2][2];
#pragma unroll
        for (int bj = 0; bj < 2; ++bj)
#pragma unroll
            for (int n = 0; n < 2; ++n) nw[bj][n] = fuse ? *(const f32x4*)(nw_next + col0 + bj * HALF + 4 * n) : (f32x4){0.f, 0.f, 0.f, 0.f};
#pragma unroll
        for (int ai = 0; ai < 2; ++ai)
#pragma unroll
            for (int m = 0; m < 4; ++m) { const int row = row0 + ai * HALF + m * 16; const size_t off = (size_t)row * DM + col0; float ssq = 0.f;
                if ((m & 1) == 0) asm volatile("" ::: "memory");
#pragma unroll
                for (int bj = 0; bj < 2; ++bj) {
                    const f32x4 x0 = *(const f32x4*)(xin + off + bj * HALF), x1 = *(const f32x4*)(xin + off + bj * HALF + 4);
                    const f32x4 y0 = x0 + acc[ai][bj][m][0], y1 = x1 + acc[ai][bj][m][1];
                    *(f32x4*)(xout + off + bj * HALF) = y0; *(f32x4*)(xout + off + bj * HALF + 4) = y1;
                    if (fuse) {
                        ssq += (y0[0] * y0[0] + y0[1] * y0[1]) + (y0[2] * y0[2] + y0[3] * y0[3]) + (y1[0] * y1[0] + y1[1] * y1[1]) + (y1[2] * y1[2] + y1[3] * y1[3]);
                        const f32x4 h0 = y0 * nw[bj][0], h1 = y1 * nw[bj][1];
                        u32x4 o; o.x = pk2(h0[0], h0[1]); o.y = pk2(h0[2], h0[3]); o.z = pk2(h1[0], h1[1]); o.w = pk2(h1[2], h1[3]);
                        *(u32x4*)(hout + off + bj * HALF) = o; } }
                if (fuse) { ssq += __shfl_xor(ssq, 16); ssq += __shfl_xor(ssq, 32); if (fq == 0) atomicAdd(rowsq + row, ssq); } }
    }
};

__device__ __forceinline__ void cvt_matrix(const float* src, int K, int N, bf16_t* dst, int ld_dst, int dst_koff, int mode, LAS float* scr, int lane, int gw, int ngw) {
    const int nblk = N / 32, nitems = (K / 64) * nblk;
    for (int item = gw; item < nitems; item += ngw) {
        const int kb = item / nblk, nb = item - kb * nblk, k0 = 64 * kb, n0 = 32 * nb;
        const float* sp = src + (size_t)(k0 + (lane >> 5)) * N + n0 + (lane & 31);
        float v[32];
#pragma unroll
        for (int i = 0; i < 32; ++i) v[i] = __builtin_nontemporal_load(sp + (size_t)(2 * i) * N);
#pragma unroll
        for (int i = 0; i < 32; ++i) scr[(2 * i + (lane >> 5)) * 33 + (lane & 31)] = v[i];
        asm volatile("s_waitcnt lgkmcnt(0)" ::: "memory");
        int drow0 = n0;
        if (mode == 1) drow0 = n0 < 7168 ? n0 : (n0 < 7200 ? 11264 : (n0 < 11296 ? n0 - 32 : n0 + 224));
        const int c = lane & 7;
#pragma unroll
        for (int j = 0; j < 4; ++j) { const int n = (lane >> 3) + 8 * j; float f[8];
#pragma unroll
            for (int i = 0; i < 8; ++i) f[i] = scr[(8 * c + i) * 33 + n];
            *(u32x4*)(dst + (size_t)(drow0 + n) * ld_dst + dst_koff + k0 + 8 * c) = pack8(f); }
        asm volatile("s_waitcnt lgkmcnt(0)" ::: "memory");
    }
}
__device__ __forceinline__ void phase_convert(const Params& P, LAS unsigned char* lds) {
    const int tid_ = opq(threadIdx.x), lane = tid_ & 63, wave = tid_ >> 6;
    LAS float* scr = (LAS float*)(lds + wave * 8448);
    const int gw = blockIdx.x * 8 + wave, ngw = gridDim.x * 8;
#pragma unroll 1
    for (int L = 0; L < 4; ++L) {
        cvt_matrix(P.w_in + (size_t)L * DM * NIN_SRC, DM, NIN_SRC, P.bt_in() + (size_t)L * NIN_PAD * DM, DM, 0, 1, scr, lane, gw, ngw);
#pragma unroll 1
        for (int g = 0; g < 4; ++g) cvt_matrix(P.pool_w + ((size_t)L * 4 + g) * 65536, 256, 256, P.bt_grp() + ((size_t)L * 4 + g) * 65536, 256, 0, 0, scr, lane, gw, ngw);
        cvt_matrix(P.w_br_pool + (size_t)L * 1024 * DM, 1024, DM, P.bt_br() + (size_t)L * DM * 4096, 4096, 0, 0, scr, lane, gw, ngw);
        cvt_matrix(P.w_br_ssm + (size_t)L * 2048 * DM, 2048, DM, P.bt_br() + (size_t)L * DM * 4096, 4096, 1024, 0, scr, lane, gw, ngw);
        cvt_matrix(P.w_br_conv + (size_t)L * 1024 * DM, 1024, DM, P.bt_br() + (size_t)L * DM * 4096, 4096, 3072, 0, scr, lane, gw, ngw);
        cvt_matrix(P.w_out + (size_t)L * DM * DM, DM, DM, P.bt_out() + (size_t)L * DM * DM, DM, 0, 0, scr, lane, gw, ngw);
        u32x4* z = (u32x4*)(P.bt_in() + (size_t)L * NIN_PAD * DM + (size_t)11296 * DM);
        for (int i = blockIdx.x * 512 + tid_; i < 224 * 256; i += gridDim.x * 512) z[i] = (u32x4){0u, 0u, 0u, 0u};
    }
}

__device__ __forceinline__ void phase_rmsnorm(const float* xin, const float* w, bf16_t* hout, float* fout, float* rowsq_out = nullptr) {
    const int tid_ = opq(threadIdx.x); const int lane = tid_ & 63, wave = tid_ >> 6;
    for (int row = blockIdx.x * 8 + wave; row < M_TOK; row += gridDim.x * 8) {
        const f32x4* xr = (const f32x4*)(xin + (size_t)row * DM) + lane;
        f32x4 v[8]; float s = 0.f;
#pragma unroll
        for (int j = 0; j < 8; ++j) { v[j] = xr[64 * j]; s += (v[j][0] * v[j][0] + v[j][1] * v[j][1]) + (v[j][2] * v[j][2] + v[j][3] * v[j][3]); }
        s = wave_sum(s);
        const float rstd = rowsq_out ? 1.f : rsqrtf(s * (1.f / DM) + EPS);
        if (rowsq_out && lane == 0) rowsq_out[row] = s;
#pragma unroll
        for (int j = 0; j < 8; ++j) { const f32x4 wv = ((const f32x4*)w)[lane + 64 * j]; const f32x4 o = v[j] * rstd * wv;
            if (hout) { u32x2 pk; pk.x = pk2(o[0], o[1]); pk.y = pk2(o[2], o[3]); *(u32x2*)(hout + (size_t)row * DM + (lane + 64 * j) * 4) = pk; }
            else *(f32x4*)(fout + (size_t)row * DM + (lane + 64 * j) * 4) = o; }
    }
}

__device__ __forceinline__ void phase_prep(const Params& P, int L) {
    const int gtid = blockIdx.x * 512 + opq(threadIdx.x), gsz = gridDim.x * 512;
    const u32x4 zero4 = (u32x4){0u, 0u, 0u, 0u};
    for (int i = gtid; i < M_TOK; i += gsz) P.rowsq()[i] = 0.f;
    for (int it = gtid; it < 512 * 128; it += gsz) {
        int ch8 = it & 127, blk = it >> 7;
        if (gsz == 256 * 512) {
            const int w = it >> 9, xcd = w & 7, lt = (w >> 3) * 512 + (it & 511); blk = (xcd >> 1) * 128 + (lt >> 6); ch8 = (xcd & 1) * 64 + (lt & 63); }
        const int g = ch8 >> 5, win = 2 << g, t0 = blk * 16, pos0 = t0 & 4095;
        const bf16_t* up = P.proj() + (size_t)t0 * NPROJ + ch8 * 8;
        float s[8];
#pragma unroll
        for (int i = 0; i < 8; ++i) s[i] = 0.f;
        const int nh = (win - 1) < pos0 ? (win - 1) : pos0;
        for (int i = 1; i <= nh; ++i) { float f[8]; unpack8(*(const u32x4*)(up - (ptrdiff_t)i * NPROJ), f);
#pragma unroll
            for (int k = 0; k < 8; ++k) s[k] += f[k]; }
#pragma unroll 1
        for (int jb = 0; jb < 16; jb += 4) {
            u32x4 cu[4], ol[4];
#pragma unroll
            for (int r = 0; r < 4; ++r) cu[r] = *(const u32x4*)(up + (ptrdiff_t)(jb + r) * NPROJ);
#pragma unroll
            for (int r = 0; r < 4; ++r) { const int jo = jb + r - win + 1; ol[r] = zero4; if (pos0 + jo >= 0) ol[r] = *(const u32x4*)(up + (ptrdiff_t)jo * NPROJ); }
#pragma unroll
            for (int r = 0; r < 4; ++r) {
                float cur[8], o[8], d[8]; unpack8(cu[r], cur); unpack8(ol[r], o);
                const int pos = pos0 + jb + r; const int cnt = (pos + 1) < win ? (pos + 1) : win; const float inv = 1.f / (float)cnt;
#pragma unroll
                for (int k = 0; k < 8; ++k) { s[k] += cur[k]; d[k] = s[k] * inv - cur[k]; s[k] -= o[k]; }
                *(u32x4*)(P.dpool() + (size_t)(t0 + jb + r) * 1024 + ch8 * 8) = pack8(d);
            }
        }
    }
    for (int it = gtid; it < 512 * 384; it += gsz) {
        int ch8 = it % 384, blk = it / 384;
        if (gsz == 256 * 512) {
            const int w = gtid >> 9, xcd = w & 7, gq = xcd >> 1, bq = xcd & 1;
            const int j = (w >> 3) * 512 + (gtid & 511) + (it >= gsz ? 16384 : 0), bl = j / 96, cl = j - bl * 96;
            blk = bq * 256 + bl; ch8 = cl < 64 ? 64 * gq + cl : (cl < 80 ? 256 + 16 * gq + (cl - 64) : 320 + 16 * gq + (cl - 80)); }
        const int ch = ch8 * 8, t0 = blk * 16, pos0 = t0 & 4095;
        const float* cw = P.ssm_conv_w + (size_t)L * 4 * 3072 + ch; const float* cb = P.ssm_conv_b + (size_t)L * 3072 + ch;
        float w0[8], w1[8], w2[8], w3[8], bb[8];
#pragma unroll
        for (int k = 0; k < 8; ++k) { w0[k] = cw[k]; w1[k] = cw[3072 + k]; w2[k] = cw[2 * 3072 + k]; w3[k] = cw[3 * 3072 + k]; bb[k] = cb[k]; }
        const bf16_t* src = P.proj() + (size_t)t0 * NPROJ + 4096 + ch;
        float x1[8], x2[8], x3[8];
#pragma unroll
        for (int k = 0; k < 8; ++k) { x1[k] = 0.f; x2[k] = 0.f; x3[k] = 0.f; }
        if (pos0 >= 3) { unpack8(*(const u32x4*)(src - (ptrdiff_t)1 * NPROJ), x1); unpack8(*(const u32x4*)(src - (ptrdiff_t)2 * NPROJ), x2); unpack8(*(const u32x4*)(src - (ptrdiff_t)3 * NPROJ), x3); }
#pragma unroll 1
        for (int jb = 0; jb < 16; jb += 8) {
            u32x4 cu[8];
#pragma unroll
            for (int r = 0; r < 8; ++r) cu[r] = *(const u32x4*)(src + (ptrdiff_t)(jb + r) * NPROJ);
#pragma unroll
            for (int r = 0; r < 8; ++r) {
                float cur[8], o[8]; unpack8(cu[r], cur);
#pragma unroll
                for (int k = 0; k < 8; ++k) { const float a = bb[k] + w0[k] * x3[k] + w1[k] * x2[k] + w2[k] * x1[k] + w3[k] * cur[k]; o[k] = siluf_(a); x3[k] = x2[k]; x2[k] = x1[k]; x1[k] = cur[k]; }
                *(u32x4*)(P.xbc() + (size_t)(t0 + jb + r) * 3072 + ch) = pack8(o);
            }
        }
    }
    for (int it = gtid; it < 512 * 128; it += gsz) {
        const int ch8 = it & 127, blk = it >> 7, ch = ch8 * 8, t0 = blk * 16, pos0 = t0 & 4095;
        const float* cw = P.sc_conv_w + (size_t)L * 3 * 1024 + ch;
        float w0[8], w1[8], w2[8];
#pragma unroll
        for (int k = 0; k < 8; ++k) { w0[k] = cw[k]; w1[k] = cw[1024 + k]; w2[k] = cw[2048 + k]; }
        const bf16_t* base = P.proj() + (size_t)t0 * NPROJ + 7168 + ch;
        float m1[8], m2[8];
#pragma unroll
        for (int k = 0; k < 8; ++k) { m1[k] = 0.f; m2[k] = 0.f; }
        if (pos0 >= 2) { float a[8], b[8], c[8], d[8];
            unpack8(*(const u32x4*)(base - (ptrdiff_t)1 * NPROJ + 1024), a); unpack8(*(const u32x4*)(base - (ptrdiff_t)1 * NPROJ + 2048), b);
            unpack8(*(const u32x4*)(base - (ptrdiff_t)2 * NPROJ + 1024), c); unpack8(*(const u32x4*)(base - (ptrdiff_t)2 * NPROJ + 2048), d);
#pragma unroll
            for (int k = 0; k < 8; ++k) { m1[k] = a[k] * b[k]; m2[k] = c[k] * d[k]; } }
#pragma unroll 1
        for (int jb = 0; jb < 16; jb += 4) {
            u32x4 rb[4], rc[4], rv[4], rg[4];
#pragma unroll
            for (int r = 0; r < 4; ++r) { const bf16_t* rp = base + (ptrdiff_t)(jb + r) * NPROJ;
                rb[r] = *(const u32x4*)(rp); rc[r] = *(const u32x4*)(rp + 1024); rv[r] = *(const u32x4*)(rp + 2048); rg[r] = *(const u32x4*)(rp + 3072); }
#pragma unroll
            for (int r = 0; r < 4; ++r) {
                float vb[8], vc[8], vv[8], vg[8], o[8];
                unpack8(rb[r], vb); unpack8(rc[r], vc); unpack8(rv[r], vv); unpack8(rg[r], vg);
#pragma unroll
                for (int k = 0; k < 8; ++k) { const float mc = vc[k] * vv[k]; const float cv = w0[k] * m2[k] + w1[k] * m1[k] + w2[k] * mc; o[k] = vb[k] * cv * siluf_(vg[k]); m2[k] = m1[k]; m1[k] = mc; }
                *(u32x4*)(P.act() + (size_t)(t0 + jb + r) * 4096 + 3072 + ch) = pack8(o);
            }
        }
    }
}

__device__ __forceinline__ void ssd_dt_scan(const Params& P, int L, int m0, int g, int bc, LAS float* acum, LAS float* aux, int mode) {
    const int tid_ = opq(threadIdx.x); const int lane = tid_ & 63, e = tid_ >> 6, h = g * 8 + e;
    const float bias = P.ssm_dt_bias[L * 32 + h], a = -expf(P.ssm_a_log[L * 32 + h]);
    const float d0 = softplusf_(P.dt()[(size_t)(m0 + lane) * 32 + h] + bias), d1 = softplusf_(P.dt()[(size_t)(m0 + 64 + lane) * 32 + h] + bias);
    const float c0 = wave_scan_incl(d0 * a, lane); const float tot0 = __shfl(c0, 63);
    const float c1 = wave_scan_incl(d1 * a, lane) + tot0; const float alast = __shfl(c1, 63);
    acum[e * 128 + lane] = c0; acum[e * 128 + 64 + lane] = c1;
    if (mode == 0) { aux[e * 128 + lane] = d0 * __expf(alast - c0); aux[e * 128 + 64 + lane] = d1 * __expf(alast - c1);
        if (lane == 0) P.decay()[bc * 32 + h] = __expf(alast); }
    else { aux[e * 128 + lane] = d0; aux[e * 128 + 64 + lane] = d1; }
}

__device__ __forceinline__ void ssd_states_unit(const Params& P, int L, int unit, LAS unsigned char* lds) {
    const int tid = opq(threadIdx.x), lane = tid & 63, w = tid >> 6, fr = lane & 15, fq = lane >> 4, q = fr >> 2, pp = lane & 3;
    const int g = unit & 3, bc = unit >> 2, m0 = bc * 128;
    LAS unsigned char* Bm = lds;
    LAS unsigned char* XW = lds + 36864;
    LAS float* acum = (LAS float*)(lds + 102400); LAS float* wl = (LAS float*)(lds + 106496);
    ssd_dt_scan(P, L, m0, g, bc, acum, wl, 0);
#pragma unroll
    for (int it = 0; it < 4; ++it) { const int idx = it * 512 + tid, row = idx >> 4, c = idx & 15;
        *(LAS u32x4*)(Bm + row * 288 + c * 16) = *(const u32x4*)(P.xbc() + (size_t)(m0 + row) * 3072 + 2048 + g * 128 + c * 8); }
    __syncthreads();
#pragma unroll 1
    for (int pass = 0; pass < 2; ++pass) {
#pragma unroll
        for (int it = 0; it < 8; ++it) { const int idx = it * 512 + tid, row = idx >> 5, c = idx & 31, hh = c >> 3, p8 = (c & 7) * 8;
            float f[8]; unpack8(*(const u32x4*)(P.xbc() + (size_t)(m0 + row) * 3072 + g * 512 + (pass * 4 + hh) * 64 + p8), f);
            const float wv = wl[(pass * 4 + hh) * 128 + row];
#pragma unroll
            for (int k = 0; k < 8; ++k) f[k] *= wv;
            *(LAS u32x4*)(XW + hh * 16384 + row * 128 + p8 * 2) = pack8(f); }
        __syncthreads();
        const int hh = w & 3, ph = w >> 2;
        f32x4 acc[2][8];
#pragma unroll
        for (int a = 0; a < 2; ++a)
#pragma unroll
            for (int b = 0; b < 8; ++b) acc[a][b] = (f32x4){0.f, 0.f, 0.f, 0.f};
        const unsigned xbase = lds_addr(XW) + hh * 16384 + (8 * fq + q) * 128 + (ph * 32 + 4 * pp) * 2;
        const unsigned bbase = lds_addr(Bm) + (8 * fq + q) * 288 + (4 * pp) * 2;
#pragma unroll
        for (int ks = 0; ks < 4; ++ks) {
            bf16x8 xf0, xf1; tr_frag2<512, 32>(xbase + ks * 4096, xf0, xf1);
#pragma unroll
            for (int nh = 0; nh < 2; ++nh) { bf16x8 bf[4]; tr_frag4<1152, 32>(bbase + ks * 9216 + nh * 128, bf);
#pragma unroll
                for (int nn = 0; nn < 4; ++nn) { const int nt = nh * 4 + nn;
                    acc[0][nt] = __builtin_amdgcn_mfma_f32_16x16x32_bf16(bf[nn], xf0, acc[0][nt], 0, 0, 0);
                    acc[1][nt] = __builtin_amdgcn_mfma_f32_16x16x32_bf16(bf[nn], xf1, acc[1][nt], 0, 0, 0); } }
        }
        const int h = g * 8 + pass * 4 + hh; float* sp = P.states() + (size_t)(bc * 32 + h) * 8192;
#pragma unroll
        for (int pt = 0; pt < 2; ++pt)
#pragma unroll
            for (int nt = 0; nt < 8; ++nt) *(f32x4*)(sp + ((2 * ph + pt) * 16 + fr) * 128 + nt * 16 + 4 * fq) = acc[pt][nt];
        __syncthreads();
    }
}

__device__ __forceinline__ void phase_scan(const Params& P) {
    const int gtid = blockIdx.x * 512 + opq(threadIdx.x), gsz = gridDim.x * 512;
    for (int it0 = gtid; it0 < 2 * 32 * 2048; it0 += gsz) {
        int it = it0;
        if (gsz == 256 * 512) { const int w = it0 >> 9, t = it0 & 511, xcd = w & 7, k = w >> 3, idx = k * 512 + t; it = ((((xcd & 1) * 32) + (xcd >> 1) * 8 + (idx >> 11)) << 11) | (idx & 2047); }
        const int e4 = it & 2047, bh = it >> 11, b = bh >> 5, h = bh & 31;
        f32x4 carry = (f32x4){0.f, 0.f, 0.f, 0.f};
#pragma unroll 1
        for (int cb = 0; cb < 32; cb += 8) {
            f32x4 st[8]; float dec[8];
#pragma unroll
            for (int k = 0; k < 8; ++k) { const size_t idx = (size_t)((b * 32 + cb + k) * 32 + h); st[k] = *(const f32x4*)(P.states() + idx * 8192 + e4 * 4); dec[k] = P.decay()[idx]; }
            __builtin_amdgcn_sched_barrier(0);
#pragma unroll
            for (int k = 0; k < 8; ++k) { const size_t idx = (size_t)((b * 32 + cb + k) * 32 + h);
                u32x2 o; o.x = pk2(carry[0], carry[1]); o.y = pk2(carry[2], carry[3]);
                *(u32x2*)(P.prev() + idx * 8192 + e4 * 4) = o;
                carry = carry * dec[k] + st[k]; }
        }
    }
}

__device__ __forceinline__ void ssd_out_unit(const Params& P, int L, int unit, LAS unsigned char* lds) {
    const int tid = opq(threadIdx.x), lane = tid & 63, w = tid >> 6, fr0 = lane & 15, fq0 = lane >> 4;
    const int g = unit & 3, bc = unit >> 2, m0 = bc * 128;
    LAS unsigned char* Cm = lds; LAS unsigned char* Bm = lds + 34816;
    LAS unsigned char* X = lds;
    LAS float* acum = (LAS float*)(lds + 131072); LAS float* dts = (LAS float*)(lds + 135168); LAS float* red = (LAS float*)(lds + 139264);
    ssd_dt_scan(P, L, m0, g, bc, acum, dts, 1);
#pragma unroll
    for (int it = 0; it < 4; ++it) { const int idx = it * 512 + tid, row = idx >> 4, c = idx & 15;
        const bf16_t* rp = P.xbc() + (size_t)(m0 + row) * 3072 + 2048 + g * 128 + c * 8;
        *(LAS u32x4*)(Bm + row * 272 + c * 16) = *(const u32x4*)(rp); *(LAS u32x4*)(Cm + row * 272 + c * 16) = *(const u32x4*)(rp + 512); }
    __syncthreads();
    const int pair = w & 3, hq = w >> 2, lt0 = pair, lt1 = 7 - pair;
    f32x4 cb0[4], cb1[8];
#pragma unroll
    for (int i = 0; i < 4; ++i) cb0[i] = (f32x4){0.f, 0.f, 0.f, 0.f};
#pragma unroll
    for (int i = 0; i < 8; ++i) cb1[i] = (f32x4){0.f, 0.f, 0.f, 0.f};
    bf16x8 cfr[2][4];
    {
        const LAS unsigned char* cr0 = Cm + (lt0 * 16 + fr0) * 272 + fq0 * 16; const LAS unsigned char* cr1 = Cm + (lt1 * 16 + fr0) * 272 + fq0 * 16;
#pragma unroll
        for (int ks = 0; ks < 4; ++ks) { cfr[0][ks] = *(const LAS bf16x8*)(cr0 + ks * 64); cfr[1][ks] = *(const LAS bf16x8*)(cr1 + ks * 64); }
    }
    const LAS unsigned char* br = Bm + fr0 * 272 + fq0 * 16;
#pragma unroll
    for (int ks = 0; ks < 4; ++ks) {
#pragma unroll
        for (int S = 0; S < 8; ++S) { if (S <= lt1) { const bf16x8 bfr = *(const LAS bf16x8*)(br + S * 16 * 272 + ks * 64);
                cb1[S] = __builtin_amdgcn_mfma_f32_16x16x32_bf16(bfr, cfr[1][ks], cb1[S], 0, 0, 0);
                if (S < 4) { if (S <= lt0) cb0[S < 4 ? S : 0] = __builtin_amdgcn_mfma_f32_16x16x32_bf16(bfr, cfr[0][ks], cb0[S < 4 ? S : 0], 0, 0, 0); } } }
    }
    __syncthreads();
#pragma unroll
    for (int it = 0; it < 16; ++it) { const int idx = it * 512 + tid, row = idx >> 6, c = idx & 63, e = c >> 3, p8 = (c & 7) * 8;
        *(LAS u32x4*)(X + e * 16384 + row * 128 + p8 * 2) = *(const u32x4*)(P.xbc() + (size_t)(m0 + row) * 3072 + g * 512 + c * 8); }
    __syncthreads();
#pragma unroll
    for (int lo = 0; lo < 2; ++lo) {
        const int li = 1 - lo;
        const int lane_ = opq(lane), fr = lane_ & 15, fq = lane_ >> 4, q = fr >> 2, pp = lane_ & 3;
        const int lt = li ? lt1 : lt0, l = lt * 16 + fr; const size_t m = (size_t)(m0 + l);
        f32x4 acc[4][4];
#pragma unroll
        for (int i = 0; i < 4; ++i)
#pragma unroll
            for (int pt = 0; pt < 4; ++pt) acc[i][pt] = (f32x4){0.f, 0.f, 0.f, 0.f};
#pragma unroll
        for (int i = 0; i < 4; ++i) { const int e = hq * 4 + i, h = g * 8 + e; const bf16_t* pv = P.prev() + (size_t)(bc * 32 + h) * 8192;
            bf16x8 pf[16];
            asm volatile("" ::: "memory");
#pragma unroll
            for (int ks = 0; ks < 4; ++ks)
#pragma unroll
                for (int pt = 0; pt < 4; ++pt) pf[ks * 4 + pt] = *(const bf16x8*)(pv + (32 * (pt >> 1) + 8 * (fr >> 2) + 4 * (pt & 1) + (fr & 3)) * 128 + ks * 32 + fq * 8);
            __builtin_amdgcn_sched_barrier(0);
#pragma unroll
            for (int ks = 0; ks < 4; ++ks)
#pragma unroll
                for (int pt = 0; pt < 4; ++pt) acc[i][pt] = __builtin_amdgcn_mfma_f32_16x16x32_bf16(pf[ks * 4 + pt], cfr[li][ks], acc[i][pt], 0, 0, 0);
            const float sc = __expf(acum[e * 128 + l]);
#pragma unroll
            for (int pt = 0; pt < 4; ++pt) acc[i][pt] *= sc;
        }
#pragma unroll
        for (int i = 0; i < 4; ++i) { const int e = hq * 4 + i;
            const unsigned xb = lds_addr(X) + e * 16384 + (4 * fq + q) * 128 + (8 * pp) * 2;
            const float al = acum[e * 128 + l];
#pragma unroll
            for (int u = 0; u < (li ? 4 : 2); ++u) { if (2 * u <= lt) {
                    float gv[8];
#pragma unroll
                    for (int t = 0; t < 2; ++t) { const int S = 2 * u + t; const f32x4 cbt = li ? cb1[S] : cb0[S < 4 ? S : 0];
                        const f32x4 as = *(const LAS f32x4*)(acum + e * 128 + S * 16 + 4 * fq), ds = *(const LAS f32x4*)(dts + e * 128 + S * 16 + 4 * fq);
#pragma unroll
                        for (int j = 0; j < 4; ++j) { const int s = S * 16 + 4 * fq + j; const float v = cbt[j] * __expf(al - as[j]) * ds[j]; gv[4 * t + j] = (s <= l) ? v : 0.f; } }
                    const bf16x8 gf = __builtin_bit_cast(bf16x8, pack8(gv));
                    bf16x8 xf[4]; tr_frag4o<2048, 8, 64, 72>(xb + u * 4096, xf);
#pragma unroll
                    for (int pt = 0; pt < 4; ++pt) acc[i][pt] = __builtin_amdgcn_mfma_f32_16x16x32_bf16(xf[pt], gf, acc[i][pt], 0, 0, 0); } }
        }
        float ss = 0.f;
        u32x4 zz[8];
        asm volatile("" ::: "memory");
#pragma unroll
        for (int i = 0; i < 4; ++i)
#pragma unroll
            for (int k = 0; k < 2; ++k) zz[i * 2 + k] = *(const u32x4*)(P.proj() + m * NPROJ + 2048 + g * 512 + (hq * 4 + i) * 64 + 32 * k + 8 * fq);
        __builtin_amdgcn_sched_barrier(0);
#pragma unroll
        for (int i = 0; i < 4; ++i) { const int e = hq * 4 + i, h = g * 8 + e; const float Dk = P.ssm_d[L * 32 + h];
#pragma unroll
            for (int k = 0; k < 2; ++k) { const int p = 32 * k + 8 * fq;
                float xf_[8], zf[8]; unpack8(*(const LAS u32x4*)(X + e * 16384 + l * 128 + p * 2), xf_); unpack8(zz[i * 2 + k], zf);
#pragma unroll
                for (int j = 0; j < 4; ++j) { const float v0 = (acc[i][2 * k][j] + xf_[j] * Dk) * siluf_(zf[j]), v1 = (acc[i][2 * k + 1][j] + xf_[4 + j] * Dk) * siluf_(zf[4 + j]);
                    acc[i][2 * k][j] = v0; acc[i][2 * k + 1][j] = v1; ss += v0 * v0 + v1 * v1; } } }
        ss += __shfl_xor(ss, 16); ss += __shfl_xor(ss, 32);
        if (fq == 0) red[hq * 128 + l] = ss;
        __syncthreads();
        const float r = rsqrtf((red[l] + red[128 + l]) * (1.f / 512.f) + EPS);
#pragma unroll
        for (int i = 0; i < 4; ++i) { const int e = hq * 4 + i; if ((i & 1) == 0) asm volatile("" ::: "memory");
#pragma unroll
            for (int k = 0; k < 2; ++k) { const int ch = g * 512 + e * 64 + 32 * k + 8 * fq;
                const f32x4 nw0 = *(const f32x4*)(P.ssm_norm_w + (size_t)L * 2048 + ch), nw1 = *(const f32x4*)(P.ssm_norm_w + (size_t)L * 2048 + ch + 4);
                const f32x4 va = acc[i][2 * k], vb = acc[i][2 * k + 1];
                u32x4 o; o.x = pk2(va[0] * r * nw0[0], va[1] * r * nw0[1]); o.y = pk2(va[2] * r * nw0[2], va[3] * r * nw0[3]);
                o.z = pk2(vb[0] * r * nw1[0], vb[1] * r * nw1[1]); o.w = pk2(vb[2] * r * nw1[2], vb[3] * r * nw1[3]);
                *(u32x4*)(P.act() + m * 4096 + 1024 + ch) = o; } }
    }
    __syncthreads();
}


#define XB_TMO      128
#define XB_XCNT(j)  (256  + 64 * (j))
#define XB_XSUB(j)  (1280 + 64 * (j))
#define XB_XGEN(j)  (2304 + 64 * (j))
#define XB_TOP      3328
#define XB_TOPGEN   3392
#define XCD_BAR_WORDS 3456
#define XB_SPIN_CAP (1u << 18)
__device__ __forceinline__ unsigned xb_ld(unsigned* p)              { return __hip_atomic_load(p, __ATOMIC_RELAXED, __HIP_MEMORY_SCOPE_AGENT); }
__device__ __forceinline__ unsigned xb_add(unsigned* p, unsigned v) { return __hip_atomic_fetch_add(p, v, __ATOMIC_RELAXED, __HIP_MEMORY_SCOPE_AGENT); }
__device__ __forceinline__ unsigned xb_xcc_id() { return (unsigned)__builtin_amdgcn_s_getreg((3 << 11) | 20) & 0xFu; }
#define XB_SPIN(cond, bar) do { unsigned _sp = 0; while (cond) { __builtin_amdgcn_s_sleep(1); \
    if ((++_sp & 255u) == 0u) { if (xb_ld(&(bar)[XB_TMO])) break; if (_sp > XB_SPIN_CAP) { atomicAdd(&(bar)[XB_TMO], 1u); break; } } } } while (0)
struct XcdBarrier { unsigned* bar; unsigned x; volatile LAS unsigned* st; };
__device__ __forceinline__ XcdBarrier xcd_barrier_post(unsigned* bar, volatile LAS unsigned* st) {
    XcdBarrier b; b.bar = bar; b.x = xb_xcc_id(); b.st = st;
    if (threadIdx.x == 0) (void)xb_add(&bar[XB_XCNT(b.x)], 1u);
    return b;
}
__device__ __forceinline__ void xcd_barrier_complete(unsigned* bar, unsigned x, unsigned& nloc, unsigned& nx) {
    const unsigned G = gridDim.x * gridDim.y * gridDim.z;
    unsigned sum, cnt, mine, sp = 0u;
    for (;;) {
        sum = 0u; cnt = 0u; mine = 0u;
#pragma unroll
        for (unsigned j = 0; j < 16; ++j) { const unsigned c = xb_ld(&bar[XB_XCNT(j)]); sum += c; cnt += (c > 0u) ? 1u : 0u; mine = (j == x) ? c : mine; }
        if (sum == G) break;
        __builtin_amdgcn_s_sleep(1);
        if ((++sp & 255u) == 0u) { if (xb_ld(&bar[XB_TMO])) break; if (sp > XB_SPIN_CAP) { atomicAdd(&bar[XB_TMO], 1u); break; } }
    }
    nloc = mine > 0u ? mine : 1u; nx = cnt > 0u ? cnt : 1u;
}
__device__ __forceinline__ void xcd_barrier(const XcdBarrier& b) {
    asm volatile("s_waitcnt vmcnt(0)" ::: "memory");
    __syncthreads();
    if (threadIdx.x == 0) {
        unsigned* bar = b.bar;
        __builtin_amdgcn_s_waitcnt(0);
        unsigned nloc = b.st[0], nx = b.st[1];
        if (nloc == 0u) { xcd_barrier_complete(bar, b.x, nloc, nx); b.st[0] = nloc; b.st[1] = nx; }
        const unsigned old = xb_add(&bar[XB_XSUB(b.x)], 1u);
        const unsigned gen = old / nloc;
        if (old + 1u == (gen + 1u) * nloc) {
            __builtin_amdgcn_fence(__ATOMIC_RELEASE, "agent");
            asm volatile("s_waitcnt vmcnt(0)" ::: "memory");
            const unsigned og = xb_add(&bar[XB_TOP], 1u);
            const unsigned tg = og / nx;
            if (og + 1u == (tg + 1u) * nx) xb_add(&bar[XB_TOPGEN], 1u);
            else XB_SPIN(xb_ld(&bar[XB_TOPGEN]) == tg, bar);
            __builtin_amdgcn_fence(__ATOMIC_ACQUIRE, "agent");
            xb_add(&bar[XB_XGEN(b.x)], 1u);
            asm volatile("s_waitcnt vmcnt(0)" ::: "memory");
        } else {
            XB_SPIN(xb_ld(&bar[XB_XGEN(b.x)]) == gen, bar);
            __builtin_amdgcn_fence(__ATOMIC_ACQUIRE, "agent");
            asm volatile("s_waitcnt vmcnt(0)" ::: "memory");
        }
    }
    __syncthreads();
}

#ifndef REP_CVT
#define REP_CVT 1
#endif
#ifndef REP_NORM
#define REP_NORM 1
#endif
#ifndef REP_GIN
#define REP_GIN 1
#endif
#ifndef REP_PREP
#define REP_PREP 1
#endif
#ifndef REP_SSD
#define REP_SSD 1
#endif
#ifndef REP_GGRP
#define REP_GGRP 1
#endif
#ifndef REP_GBR
#define REP_GBR 1
#endif
#ifndef REP_GOUT
#define REP_GOUT 1
#endif
#ifndef REP_SYNC
#define REP_SYNC 1
#endif
#define GSYNC() do { for (int r_ = 0; r_ < REP_SYNC; ++r_) xcd_barrier(xb); } while (0)
__global__ void __launch_bounds__(512, 2) hybrid_fwd(Params P) {
    extern __shared__ __attribute__((aligned(16))) unsigned char shm_[];
    LAS unsigned char* lds = (LAS unsigned char*)shm_;
    cg::grid_group grid = cg::this_grid();
    const int G = (int)gridDim.x, c = (int)blockIdx.x;
    volatile LAS unsigned* xst = (volatile LAS unsigned*)(lds + LDS_BYTES - 16);
    if (threadIdx.x == 0) { xst[0] = 0u; xst[1] = 0u; xst[2] = 0u; xst[3] = 0u; }
    __syncthreads();
    const XcdBarrier xb = xcd_barrier_post(P.bar(), xst);
    for (int r = 0; r < REP_CVT; ++r) phase_convert(P, lds);
    phase_rmsnorm(P.x, P.norm_w, P.h(), nullptr, P.rowsq());
    grid.sync();
    GSYNC();
#pragma unroll 1
    for (int L = 0; L < 4; ++L) {
        const float* xin = L == 0 ? P.x : P.xcur();
        for (int r = 0; r < REP_GIN; ++r)
        { { const int t_ = opq(threadIdx.x); const float* bgp = P.b_gate + (size_t)L * 6144 + t_ * 12;
            const f32x4 b0 = *(const f32x4*)bgp, b1 = *(const f32x4*)(bgp + 4), b2 = *(const f32x4*)(bgp + 8);
            LAS u32x2* bl = (LAS u32x2*)(lds + 131072 + t_ * 24);
            u32x2 o0, o1, o2; o0.x = pk2(b0[0], b0[1]); o0.y = pk2(b0[2], b0[3]); o1.x = pk2(b1[0], b1[1]); o1.y = pk2(b1[2], b1[3]); o2.x = pk2(b2[0], b2[1]); o2.y = pk2(b2[2], b2[3]);
            bl[0] = o0; bl[1] = o1; bl[2] = o2;
            LAS _Float16* lr = (LAS _Float16*)(lds + 143360);
#pragma unroll
            for (int k = 0; k < 4; ++k) { const f32x4 q = *(const f32x4*)(P.rowsq() + t_ * 16 + k * 4);
#pragma unroll
                for (int j = 0; j < 4; ++j) lr[t_ * 16 + k * 4 + j] = (_Float16)rsqrtf(q[j] * (1.f / DM) + EPS); }
            __syncthreads(); }
          { Gemm g; g.A = P.h(); g.Bt = P.bt_in() + (size_t)L * NIN_PAD * DM; g.lda = DM; g.ldb = DM; g.K = DM; g.nM = 32; g.nN = 69; g.a_pn_off = 0;
            StaticOrder S; S.init(32, 69, G, c); EpiInProjU E; E.proj = P.proj(); E.dt = P.dt(); E.gates = P.gates(); E.lbias = lds + 131072; E.lrstd = (LAS const _Float16*)(lds + 143360);
            gemm_phase<EpiInProjU, true>(lds, g, S, E); } }
        GSYNC();
        for (int r = 0; r < REP_PREP; ++r) phase_prep(P, L);
        GSYNC();
        const bool split = (G == 256);
        for (int r = 0; r < REP_SSD; ++r) { if (split) { if (c < 128) { const int xcd = c & 7, k2 = c >> 3, ub = ((xcd & 1) * 32 + 2 * k2) * 4 + (xcd >> 1); ssd_states_unit(P, L, ub, lds); ssd_states_unit(P, L, ub + 4, lds); } } else for (int u = c; u < 256; u += G) ssd_states_unit(P, L, u, lds); }
        for (int r = 0; r < REP_GGRP; ++r)
        { Gemm g; g.A = P.dpool(); g.Bt = P.bt_grp() + (size_t)L * 1024 * 256; g.lda = 1024; g.ldb = 256; g.K = 256; g.nM = 32; g.nN = 4; g.a_pn_off = 256;
          StaticOrder S; if (split) S.init(32, 4, 128, c >= 128 ? c - 128 : 1 << 20); else S.init(32, 4, G, c); EpiGrp E; E.act = P.act(); E.gates = P.gates(); E.scale = P.pool_scale + (size_t)L * 1024;
          gemm_phase(lds, g, S, E); }
        GSYNC();
        for (int r = 0; r < REP_SSD; ++r) phase_scan(P);
        GSYNC();
        for (int r = 0; r < REP_SSD; ++r) { if (split) ssd_out_unit(P, L, ((c & 1) * 32 + (c >> 3)) * 4 + ((c & 7) >> 1), lds); else for (int u = c; u < 256; u += G) ssd_out_unit(P, L, u, lds); }
        GSYNC();
        for (int r = 0; r < REP_GBR; ++r)
        { Gemm g; g.A = P.act(); g.Bt = P.bt_br() + (size_t)L * DM * 4096; g.lda = 4096; g.ldb = 4096; g.K = 4096; g.nM = 32; g.nN = 8; g.a_pn_off = 0;
          StaticOrder S; S.init(32, 8, G, c); EpiBr E; E.merged = P.merged(); E.gates = P.gates();
          gemm_phase(lds, g, S, E); }
        GSYNC();
        for (int r = 0; r < REP_GOUT; ++r)
        { Gemm g; g.A = P.merged(); g.Bt = P.bt_out() + (size_t)L * DM * DM; g.lda = DM; g.ldb = DM; g.K = DM; g.nM = 32; g.nN = 8; g.a_pn_off = 0;
          StaticOrder S; S.init(32, 8, G, c); EpiOut E; E.xin = xin; E.xout = (r == REP_GOUT - 1) ? P.xcur() : P.states(); E.nw_next = (L < 3) ? P.norm_w + (size_t)(L + 1) * DM : nullptr; E.hout = P.h(); E.rowsq = P.rowsq();
          gemm_phase(lds, g, S, E); }
        GSYNC();
    }
    phase_rmsnorm(P.xcur(), P.final_norm_w, nullptr, P.out);
}

extern "C" void kernel_launch(void* const* d_in, const int* in_sizes, int n_in, void* d_out, int out_size, void* d_ws, size_t ws_size, hipStream_t stream) {
    static int grid_blocks = 0;
    if (!grid_blocks) {
        int dev = 0, cus = 0, per_cu = 0;
        hipGetDevice(&dev);
        hipDeviceGetAttribute(&cus, hipDeviceAttributeMultiprocessorCount, dev);
        if (hipFuncSetAttribute((const void*)hybrid_fwd, hipFuncAttributeMaxDynamicSharedMemorySize, LDS_BYTES) != hipSuccess) fprintf(stderr, "hipFuncSetAttribute failed\n");
        if (hipOccupancyMaxActiveBlocksPerMultiprocessor(&per_cu, (const void*)hybrid_fwd, 512, LDS_BYTES) != hipSuccess || per_cu < 1) { fprintf(stderr, "occupancy query gave %d\n", per_cu); per_cu = 1; }
        (void)hipGetLastError();
        grid_blocks = cus * per_cu;
        if (grid_blocks > 256) grid_blocks = 256;
    }
    Params p{};
    const float* const* in = (const float* const*)d_in;
    p.x = in[0]; p.norm_w = in[1]; p.w_in = in[2]; p.b_gate = in[3]; p.pool_w = in[4]; p.pool_scale = in[5]; p.ssm_conv_w = in[6]; p.ssm_conv_b = in[7];
    p.ssm_dt_bias = in[8]; p.ssm_a_log = in[9]; p.ssm_d = in[10]; p.ssm_norm_w = in[11]; p.sc_conv_w = in[12]; p.w_br_pool = in[13]; p.w_br_ssm = in[14];
    p.w_br_conv = in[15]; p.w_out = in[16]; p.final_norm_w = in[17];
    p.out = (float*)d_out;
    p.ws = (unsigned char*)d_ws;
    if (WS_END > ws_size) { fprintf(stderr, "workspace too small: need %zu have %zu\n", (size_t)WS_END, ws_size); return; }
    if (hipMemsetAsync((unsigned char*)d_ws + OFF_BAR, 0, 16384, stream) != hipSuccess) { fprintf(stderr, "memset of barrier words failed\n"); return; }
    void* args[] = {&p};
    hipError_t e = hipLaunchCooperativeKernel((const void*)hybrid_fwd, dim3(grid_blocks), dim3(512), args, LDS_BYTES, stream);
    if (e != hipSuccess) fprintf(stderr, "cooperative launch failed: %s (grid %d)\n", hipGetErrorString(e), grid_blocks);
}
```
